# Optimizing an MI355X kernel written in HIP

```python
import jax, jax.numpy as jnp
from jax import lax
import numpy as np

D_MODEL = 1024
BATCH = 8
SEQ = 4096
DEPTH = 4

N_HEADS = 8
QK_NOPE = 64
QK_ROPE = 32
QK_HEAD = QK_NOPE + QK_ROPE
V_HEAD = 64
Q_LORA = 384
KV_LORA = 256
ATTN_WIDTH = N_HEADS * V_HEAD
CONV_WIDTH = D_MODEL - ATTN_WIDTH
CONV_TAPS = 3
IN_COLS = Q_LORA + KV_LORA + QK_ROPE + 3 * CONV_WIDTH
D_FF = 4 * D_MODEL
PLE_DIM = 256
ROPE_THETA = 10000.0
Q_BLOCK = 128
EPS = 1e-6
MAX_POS_OFFSET = 1024

kernel_name = "hybrid_mla_shortconv_trunk"


def rmsnorm(x, g):
    xf = x.astype(jnp.float32)
    y = xf * lax.rsqrt(jnp.mean(xf * xf, axis=-1, keepdims=True) + EPS)
    return (y * g.astype(jnp.float32)).astype(x.dtype)


def rope_tables(positions):
    inv_freq = 1.0 / (ROPE_THETA ** (jnp.arange(0, QK_ROPE, 2, dtype=jnp.float32) / QK_ROPE))
    ang = positions.astype(jnp.float32)[..., None] * inv_freq
    return jnp.cos(ang)[:, :, None, :], jnp.sin(ang)[:, :, None, :]


def apply_rope(x, cos, sin):
    half = QK_ROPE // 2
    x1 = x[..., :half].astype(jnp.float32)
    x2 = x[..., half:].astype(jnp.float32)
    return jnp.concatenate([x1 * cos - x2 * sin, x2 * cos + x1 * sin], axis=-1).astype(x.dtype)


def causal_block_attention(q, k, v):
    b, s = q.shape[0], q.shape[1]
    scale = QK_HEAD ** -0.5
    n_blocks = s // Q_BLOCK
    k_idx = jnp.arange(s)

    def one_block(i):
        start = i * Q_BLOCK
        qb = lax.dynamic_slice_in_dim(q, start, Q_BLOCK, axis=1)
        sc = jnp.einsum('bqhd,bkhd->bhqk', qb, k, preferred_element_type=jnp.float32) * scale
        q_idx = start + jnp.arange(Q_BLOCK)
        sc = jnp.where(k_idx[None, :] <= q_idx[:, None], sc, -jnp.inf)
        pr = jax.nn.softmax(sc, axis=-1).astype(v.dtype)
        return jnp.einsum('bhqk,bkhd->bqhd', pr, v)

    out = lax.map(one_block, jnp.arange(n_blocks))
    return jnp.moveaxis(out, 0, 1).reshape(b, s, N_HEADS * V_HEAD)


def mla_group(q_lat, kv_lat, k_pe, cos, sin, g_q_lat, w_uq, g_kv_lat, w_ukv,
              g_qn_nope, g_qn_rope, g_kn_nope, g_kn_rope):
    b, s = q_lat.shape[0], q_lat.shape[1]
    q = (rmsnorm(q_lat, g_q_lat) @ w_uq).reshape(b, s, N_HEADS, QK_HEAD)
    kv = (rmsnorm(kv_lat, g_kv_lat) @ w_ukv).reshape(b, s, N_HEADS, QK_NOPE + V_HEAD)
    k_nope, v = kv[..., :QK_NOPE], kv[..., QK_NOPE:]
    q_nope = rmsnorm(q[..., :QK_NOPE], g_qn_nope)
    q_pe = apply_rope(rmsnorm(q[..., QK_NOPE:], g_qn_rope), cos, sin)
    k_nope = rmsnorm(k_nope, g_kn_nope)
    k_pe = apply_rope(rmsnorm(k_pe.reshape(b, s, 1, QK_ROPE), g_kn_rope), cos, sin)
    qf = jnp.concatenate([q_nope, q_pe], axis=-1)
    kf = jnp.concatenate([k_nope, jnp.broadcast_to(k_pe, (b, s, N_HEADS, QK_ROPE))], axis=-1)
    return causal_block_attention(qf, kf, v)


def short_conv_group(gate_b, gate_c, x_in, conv_w):
    u = gate_c * x_in
    s = u.shape[1]
    up = jnp.pad(u, ((0, 0), (CONV_TAPS - 1, 0), (0, 0)))
    y = sum(conv_w[j] * up[:, CONV_TAPS - 1 - j: CONV_TAPS - 1 - j + s] for j in range(CONV_TAPS))
    return gate_b * y


def setup_inputs(seed: int = 0) -> dict:
    key = jax.random.key(seed)
    ks = jax.random.split(key, 24)

    def w(k, shape, fan_in):
        return jax.random.normal(k, (DEPTH,) + shape, jnp.float32) * fan_in ** -0.5

    def gain(k, n):
        return 1.0 + 0.02 * jax.random.normal(k, (DEPTH, n), jnp.float32)

    x = jax.random.normal(ks[0], (BATCH, SEQ, D_MODEL), jnp.float32)
    p = jax.random.normal(ks[1], (DEPTH, BATCH, SEQ, PLE_DIM), jnp.float32)
    offs = jax.random.randint(ks[2], (BATCH, 1), 0, MAX_POS_OFFSET, dtype=jnp.int32)
    positions = (offs + jnp.arange(SEQ, dtype=jnp.int32)[None, :]).astype(jnp.int32)
    return {
        "x": x,
        "p": p,
        "positions": positions,
        "g_mix": gain(ks[3], D_MODEL),
        "w_in": w(ks[4], (D_MODEL, IN_COLS), D_MODEL),
        "g_q_lat": gain(ks[5], Q_LORA),
        "w_uq": w(ks[6], (Q_LORA, N_HEADS * QK_HEAD), Q_LORA),
        "g_kv_lat": gain(ks[7], KV_LORA),
        "w_ukv": w(ks[8], (KV_LORA, N_HEADS * (QK_NOPE + V_HEAD)), KV_LORA),
        "g_qn_nope": gain(ks[9], QK_NOPE),
        "g_qn_rope": gain(ks[10], QK_ROPE),
        "g_kn_nope": gain(ks[11], QK_NOPE),
        "g_kn_rope": gain(ks[12], QK_ROPE),
        "conv_w": w(ks[13], (CONV_TAPS, CONV_WIDTH), CONV_TAPS),
        "g_out_attn": gain(ks[14], ATTN_WIDTH),
        "g_out_conv": gain(ks[15], CONV_WIDTH),
        "w_o": w(ks[16], (D_MODEL, D_MODEL), D_MODEL),
        "g_mlp": gain(ks[17], D_MODEL),
        "w_up": w(ks[18], (D_MODEL, D_FF), D_MODEL),
        "w_down": w(ks[19], (D_FF, D_MODEL), D_FF),
        "g_ple": gain(ks[20], D_MODEL),
        "w_ple_gate": w(ks[21], (D_MODEL, D_MODEL), D_MODEL),
        "w_ple": w(ks[22], (PLE_DIM, D_MODEL), PLE_DIM),
    }


def reference(x, p, positions, g_mix, w_in, g_q_lat, w_uq, g_kv_lat, w_ukv,
              g_qn_nope, g_qn_rope, g_kn_nope, g_kn_rope, conv_w, g_out_attn,
              g_out_conv, w_o, g_mlp, w_up, w_down, g_ple, w_ple_gate, w_ple):
    cos, sin = rope_tables(positions)
    o1 = Q_LORA
    o2 = o1 + KV_LORA
    o3 = o2 + QK_ROPE
    o4 = o3 + CONV_WIDTH
    o5 = o4 + CONV_WIDTH
    for i in range(DEPTH):
        h = rmsnorm(x, g_mix[i])
        z = h @ w_in[i]
        attn = mla_group(z[..., :o1], z[..., o1:o2], z[..., o2:o3], cos, sin,
                         g_q_lat[i], w_uq[i], g_kv_lat[i], w_ukv[i],
                         g_qn_nope[i], g_qn_rope[i], g_kn_nope[i], g_kn_rope[i])
        conv = short_conv_group(z[..., o3:o4], z[..., o4:o5], z[..., o5:], conv_w[i])
        mixed = jnp.concatenate([rmsnorm(attn, g_out_attn[i]), rmsnorm(conv, g_out_conv[i])], axis=-1)
        x = x + mixed @ w_o[i]
        h2 = rmsnorm(x, g_mlp[i])
        x = x + jnp.square(jax.nn.relu(h2 @ w_up[i])) @ w_down[i]
        gate = jax.nn.sigmoid(rmsnorm(x, g_ple[i]) @ w_ple_gate[i])
        x = x + gate * (p[i] @ w_ple[i])
    return x
```

```cpp
#include <hip/hip_runtime.h>
#include <hip/hip_cooperative_groups.h>
#include <hip/hip_bf16.h>
#include <cstdio>
#include <cstdint>
namespace cg = cooperative_groups;

#define LAS __attribute__((address_space(3)))
typedef unsigned short bf16_t;
typedef short bf16x8 __attribute__((ext_vector_type(8)));
typedef float f32x4 __attribute__((ext_vector_type(4)));
typedef float f32x2 __attribute__((ext_vector_type(2)));
typedef unsigned u32x4 __attribute__((ext_vector_type(4)));
typedef unsigned u32x2 __attribute__((ext_vector_type(2)));

constexpr int DMODEL = 1024, BATCH = 8, SEQ = 4096, DEPTH = 4, M = BATCH * SEQ;
constexpr int NH = 8, QL = 384, KVL = 256;
constexpr int INC = 2208, INP = 2304, FF = 4096, PLE = 256;
constexpr float EPS = 1e-6f;
constexpr float QSCALE = 0.10206207261596575f * 1.4426950408889634f;

constexpr size_t MiB = 1u << 20;
constexpr size_t WS_CTL = 0, CTL_ZERO_BYTES = 64 * 1024;
constexpr size_t WS_W0 = 1 * MiB, WS_WSTRIDE = 28 * MiB;
constexpr size_t WS_XB = 85 * MiB;
constexpr size_t WS_R = 149 * MiB;
constexpr size_t WS_Z = WS_R, WS_Q = WS_R + 144 * MiB, WS_KN = WS_R + 192 * MiB, WS_V = WS_R + 224 * MiB, WS_H = WS_R;
constexpr size_t WS_MIX = 405 * MiB;
constexpr size_t WS_PB = 469 * MiB;
constexpr size_t WS_KPE = 485 * MiB;
constexpr size_t WS_COS = 487 * MiB, WS_SIN = 489 * MiB;
constexpr size_t WS_XS0 = 491 * MiB, WS_XS1 = 493 * MiB;
constexpr size_t WS_ZS = 495 * MiB;
constexpr size_t WS_ASS = 499 * MiB;
constexpr size_t WS_END = 500 * MiB;
constexpr size_t WO_IN = 0, WO_UQ = WO_IN + (size_t)INP * 1024, WO_UKV = WO_UQ + 768 * 384, WO_O = WO_UKV + 1024 * 256, WO_UP = WO_O + 1024 * 1024,
                 WO_DN = WO_UP + (size_t)4096 * 1024, WO_G = WO_DN + (size_t)4096 * 1024, WO_PLE = WO_G + 1024 * 1024, WO_END = WO_PLE + 1024 * 256;
static_assert(WO_END * 2 <= 28 * MiB, "weight buffer");

constexpr int LDS_BYTES = 147456;
constexpr int MISC_OFF = 131072 + 320;

__device__ __forceinline__ unsigned cvt_pk_bf16(float lo, float hi) { unsigned r; asm volatile("v_cvt_pk_bf16_f32 %0, %1, %2" : "=v"(r) : "v"(lo), "v"(hi)); return r; }
__device__ __forceinline__ float bf_lo(unsigned w) { return __uint_as_float(w << 16); }
__device__ __forceinline__ float bf_hi(unsigned w) { return __uint_as_float(w & 0xffff0000u); }
__device__ __forceinline__ float wave_sum(float v) {
#pragma unroll
    for (int o = 1; o < 64; o <<= 1) v += __shfl_xor(v, o);
    return v;
}
__device__ __forceinline__ float dot4(f32x4 a) { return (a[0] * a[0] + a[1] * a[1]) + (a[2] * a[2] + a[3] * a[3]); }
__device__ __forceinline__ float fq_sum(float s) { s += __shfl_xor(s, 16); s += __shfl_xor(s, 32); return s; }

namespace pg8 {
constexpr int BM = 256, BK = 64, HALF = 128, HTB = HALF * BK * 2, STAGE_BYTES = 8 * HTB, NXCD = 8, WGM = 8;
__host__ __device__ __forceinline__ int lds_byte(int r, int c) { const int st = (r >> 4) * 2 + (c >> 5), rr = r & 15, cc = c & 31, ob = rr * 64 + cc * 2; return st * 1024 + (ob ^ (((ob >> 9) & 1) << 5)); }
__host__ __device__ __forceinline__ void stage_rc(int b, int& R, int& C) { const int st = b / 1024, sb = b % 1024, swz = sb ^ (((sb >> 9) & 1) << 5); R = (st >> 1) * 16 + swz / 64; C = (st & 1) * 32 + (swz % 64) / 2; }
__host__ __device__ __forceinline__ int perm32(int rho) { const int n = rho >> 4, i = rho & 15; return 8 * (i >> 2) + 4 * n + (i & 3); }

struct Unit { int pm, pn; };
struct Gemm { const bf16_t* A; const bf16_t* Bt; int M, N, K, lda; };

struct StaticOrder {
    int nM, nN, nwg, G, c;
    __device__ void init(int M_, int N_, int G_, int c_) { nM = M_ / BM; nN = N_ / BM; nwg = nM * nN; G = G_; c = c_; }
    __device__ bool next(int i, Unit& u) const {
        const long L = (long)i * G + c; if (L >= nwg) return false;
        int wgid = (int)L; { const int q = nwg / NXCD, r = nwg % NXCD, xcd = wgid % NXCD, off = wgid / NXCD; wgid = (xcd < r ? xcd * (q + 1) : r * (q + 1) + (xcd - r) * q) + off; }
        const int nig = WGM * nN, gid = wgid / nig, fm = gid * WGM, gsz = (nM - fm) < WGM ? (nM - fm) : WGM;
        u.pm = fm + ((wgid % nig) % gsz); u.pn = (wgid % nig) / gsz; return true;
    }
};

template <class Epi, bool MID = false>
__device__ __forceinline__ void gemm_phase(LAS unsigned char* lds, const Gemm g, const StaticOrder& S, const Epi& E) {
    int tid_ = threadIdx.x; asm volatile("" : "+v"(tid_));
    const int tid = tid_, wid = __builtin_amdgcn_readfirstlane(tid >> 6), lane = tid & 63, wr = wid >> 2, wc = wid & 3, fr = lane & 15, fq = lane >> 4;
    const int K = g.K, lda = g.lda; int nt = K / BK; asm volatile("" : "+s"(nt));
    unsigned voffA[2], voffB[2];
#pragma unroll
    for (int i = 0; i < 2; ++i) { int R, C; stage_rc(tid * 16 + i * 8192, R, C); const int Rb = (R & ~31) + perm32(R & 31);
        voffA[i] = (unsigned)(R * lda + C) * 2u; voffB[i] = (unsigned)(Rb * K + C) * 2u; }
    const size_t kstep = (size_t)(BK * 2);
    const size_t hstepA = (size_t)HALF * lda * 2, hstepB = (size_t)HALF * K * 2;
    const size_t tstepA = 2 * hstepA, tstepB = 2 * hstepB;
    const unsigned ldsw = (unsigned)wid * 1024u;
    const int aoff = lds_byte(wr * 64 + fr, fq * 8), boff = lds_byte(wc * 32 + fr, fq * 8);
#define PG8_SA(b, h) (((b) * 2 + (h)) * HTB)
#define PG8_SB(b, h) ((4 + (b) * 2 + (h)) * HTB)
#define PG8_STAGE(bufoff, gbase, voff) do { _Pragma("unroll") for (int _i = 0; _i < 2; ++_i) \
        __builtin_amdgcn_global_load_lds((const unsigned*)((const char*)(gbase) + (voff)[_i]), (LAS unsigned*)(lds + (bufoff) + ldsw + _i * 8192), 16, 0, 0); } while (0)
#define PG8_LDA(dst, b, h) do { _Pragma("unroll") for (int m = 0; m < 4; ++m) _Pragma("unroll") for (int k = 0; k < 2; ++k) dst[m][k] = *(const LAS bf16x8*)(lds + PG8_SA(b, h) + aoff + m * 2048 + k * 1024); } while (0)
#define PG8_LDB(dst, b, h) do { _Pragma("unroll") for (int n = 0; n < 2; ++n) _Pragma("unroll") for (int k = 0; k < 2; ++k) dst[n][k] = *(const LAS bf16x8*)(lds + PG8_SB(b, h) + boff + n * 2048 + k * 1024); } while (0)
#define PG8_MMA(ai, bj, At, Bt) do { __builtin_amdgcn_s_setprio(1); _Pragma("unroll") for (int m = 0; m < 4; ++m) _Pragma("unroll") for (int n = 0; n < 2; ++n) _Pragma("unroll") for (int k = 0; k < 2; ++k) \
        acc[ai][bj][m][n] = __builtin_amdgcn_mfma_f32_16x16x32_bf16(Bt[n][k], At[m][k], acc[ai][bj][m][n], 0, 0, 0); __builtin_amdgcn_s_setprio(0); } while (0)
#define PG8_WAIT_V(n) asm volatile("s_waitcnt vmcnt(" #n ")" ::: "memory")
#define PG8_WAIT_L(n) asm volatile("s_waitcnt lgkmcnt(" #n ")" ::: "memory")
#define PG8_BAR __builtin_amdgcn_s_barrier()
#define PG8_SCHED __builtin_amdgcn_sched_barrier(0)
    Unit cur, nxt; int ui = 0;
    if (!S.next(0, cur)) return;
    f32x4 acc[2][2][4][2];
#pragma unroll
    for (int a = 0; a < 2; ++a)
#pragma unroll
        for (int b = 0; b < 2; ++b)
#pragma unroll
            for (int m = 0; m < 4; ++m)
#pragma unroll
                for (int n = 0; n < 2; ++n) acc[a][b][m][n] = (f32x4){0.f, 0.f, 0.f, 0.f};
    bf16x8 At[4][2], B0[2][2], B1[2][2];
    const char* cA = (const char*)g.A + (size_t)cur.pm * tstepA; const char* cB = (const char*)g.Bt + (size_t)cur.pn * tstepB;
    PG8_STAGE(PG8_SB(0, 0), cB, voffB); PG8_STAGE(PG8_SB(0, 1), cB + hstepB, voffB); PG8_STAGE(PG8_SA(0, 0), cA, voffA); PG8_STAGE(PG8_SA(0, 1), cA + hstepA, voffA);
    if (wr == 1) PG8_BAR;
    PG8_WAIT_V(2); PG8_BAR;
    PG8_STAGE(PG8_SB(1, 0), cB + kstep, voffB); PG8_STAGE(PG8_SA(1, 0), cA + kstep, voffA); PG8_STAGE(PG8_SB(1, 1), cB + hstepB + kstep, voffB);
    PG8_WAIT_V(6); PG8_BAR;
    for (;;) {
        const bool has_next = S.next(ui + 1, nxt);
        const char* nA = has_next ? (const char*)g.A + (size_t)nxt.pm * tstepA : cA; const char* nB = has_next ? (const char*)g.Bt + (size_t)nxt.pn * tstepB : cB;
#pragma nounroll
        for (int t = 0; t < nt; t += 2) {
            const bool last = (t == nt - 2);
            const char* a1 = cA + (size_t)(t + 1) * kstep;
            const char* a2 = last ? nA : cA + (size_t)(t + 2) * kstep; const char* b2 = last ? nB : cB + (size_t)(t + 2) * kstep;
            const char* a3 = a2 + kstep; const char* b3 = b2 + kstep;
            PG8_LDB(B0, 0, 0); PG8_LDB(B1, 0, 1); PG8_SCHED; PG8_LDA(At, 0, 0); PG8_STAGE(PG8_SA(1, 1), a1 + hstepA, voffA);
            PG8_WAIT_V(8); PG8_WAIT_L(0); PG8_BAR; PG8_MMA(0, 0, At, B0); PG8_MMA(0, 1, At, B1); PG8_BAR; PG8_SCHED;
            PG8_LDA(At, 0, 1); PG8_STAGE(PG8_SB(0, 0), b2, voffB); PG8_STAGE(PG8_SB(0, 1), b2 + hstepB, voffB); PG8_STAGE(PG8_SA(0, 0), a2, voffA);
            PG8_WAIT_V(8); PG8_WAIT_L(0); PG8_BAR; PG8_MMA(1, 0, At, B0); PG8_MMA(1, 1, At, B1); PG8_BAR; PG8_SCHED;
            PG8_LDB(B0, 1, 0); PG8_LDB(B1, 1, 1); PG8_SCHED; PG8_LDA(At, 1, 0); PG8_STAGE(PG8_SA(0, 1), a2 + hstepA, voffA);
            PG8_WAIT_V(8); PG8_WAIT_L(0); PG8_BAR; PG8_MMA(0, 0, At, B0); PG8_MMA(0, 1, At, B1); PG8_BAR; PG8_SCHED;
            PG8_LDA(At, 1, 1); PG8_STAGE(PG8_SB(1, 0), b3, voffB); PG8_STAGE(PG8_SB(1, 1), b3 + hstepB, voffB); PG8_STAGE(PG8_SA(1, 0), a3, voffA);
            PG8_WAIT_V(8); PG8_WAIT_L(0); PG8_BAR; PG8_MMA(1, 0, At, B0); PG8_MMA(1, 1, At, B1); PG8_BAR; PG8_SCHED;
            if constexpr (MID) { if (t == 6) E.mid(acc, cur, wr, wc, fr, fq); }
        }
        if (wr == 0) PG8_BAR;
        E(acc, cur, wr, wc, fr, fq);
        if (!has_next) break;
#pragma unroll
        for (int a = 0; a < 2; ++a)
#pragma unroll
            for (int b = 0; b < 2; ++b)
#pragma unroll
                for (int m = 0; m < 4; ++m)
#pragma unroll
                    for (int n = 0; n < 2; ++n) acc[a][b][m][n] = (f32x4){0.f, 0.f, 0.f, 0.f};
        cur = nxt; cA = nA; cB = nB; ++ui;
        if (wr == 1) PG8_BAR;
    }
    PG8_WAIT_V(0);
    PG8_BAR;
#undef PG8_SA
#undef PG8_SB
#undef PG8_STAGE
#undef PG8_LDA
#undef PG8_LDB
#undef PG8_MMA
#undef PG8_WAIT_V
#undef PG8_WAIT_L
#undef PG8_BAR
#undef PG8_SCHED
}

__device__ __forceinline__ float rstd16(const float* xs, int row, int fq, float invn) {
    const f32x4 p = *(const f32x4*)(xs + (size_t)row * 16 + fq * 4);
    const float s = fq_sum((p[0] + p[1]) + (p[2] + p[3]));
    return rsqrtf(s * invn + EPS);
}
__device__ __forceinline__ void rstd8(float (&rs)[2][4], const float* xs, int rowb, int stride, int fq, int lim, float invn) {
    f32x4 p[2][4];
#pragma unroll
    for (int ai = 0; ai < 2; ++ai)
#pragma unroll
        for (int m = 0; m < 4; ++m) { p[ai][m] = (f32x4){0.f, 0.f, 0.f, 0.f}; if (fq < lim) p[ai][m] = *(const f32x4*)(xs + (size_t)(rowb + ai * 128 + m * 16) * stride + fq * 4); }
#pragma unroll
    for (int ai = 0; ai < 2; ++ai)
#pragma unroll
        for (int m = 0; m < 4; ++m) rs[ai][m] = rsqrtf(fq_sum((p[ai][m][0] + p[ai][m][1]) + (p[ai][m][2] + p[ai][m][3])) * invn + EPS);
}
__device__ __forceinline__ u32x4 pack8(f32x4 a, f32x4 b) { u32x4 w; w.x = cvt_pk_bf16(a[0], a[1]); w.y = cvt_pk_bf16(a[2], a[3]); w.z = cvt_pk_bf16(b[0], b[1]); w.w = cvt_pk_bf16(b[2], b[3]); return w; }

struct EpiIn {
    bf16_t* z; const float* xs; float* zs; bf16_t* kpe; const float* cs; const float* sn; const float* gk;
    __device__ __forceinline__ void operator()(const f32x4 (&acc)[2][2][4][2], const Unit& u, int wr, int wc, int fr, int fq) const {
        const int colb = u.pn * 256 + wc * 32 + 8 * fq;
        float rs8[2][4]; rstd8(rs8, xs, u.pm * 256 + wr * 64 + fr, 16, fq, 4, 1.0f / 1024.0f);
#pragma unroll
        for (int ai = 0; ai < 2; ++ai)
#pragma unroll
            for (int m = 0; m < 4; ++m) {
                const int row = u.pm * 256 + ai * 128 + wr * 64 + m * 16 + fr;
                const float rs = rs8[ai][m];
                if (u.pn >= 5) {
                    const f32x4 u0 = (acc[ai][0][m][0] * rs) * (acc[ai][1][m][0] * rs), u1 = (acc[ai][0][m][1] * rs) * (acc[ai][1][m][1] * rs);
                    *(u32x4*)(z + (size_t)row * INP + 1280 + (u.pn - 5) * 128 + wc * 32 + 8 * fq) = pack8(u0, u1);
                } else
#pragma unroll
                for (int bj = 0; bj < 2; ++bj) {
                    const f32x4 v0 = acc[ai][bj][m][0] * rs, v1 = acc[ai][bj][m][1] * rs;
                    const int hb = 2 * u.pn + bj;
                    if (hb < 5) { const float s = fq_sum(dot4(v0) + dot4(v1)); if (fq == 0) zs[(size_t)row * 32 + (hb < 3 ? hb * 4 : 16 + (hb - 3) * 4) + wc] = s; }
                    if (hb == 5 && wc == 0) {
                        const float ss = fq_sum(dot4(v0) + dot4(v1)); const float rn = rsqrtf(ss * (1.0f / 32.0f) + EPS);
                        const f32x4 g1 = *(const f32x4*)(gk + 4 * fq), g2 = *(const f32x4*)(gk + 16 + 4 * fq);
                        const f32x4 c = *(const f32x4*)(cs + (size_t)row * 16 + 4 * fq), s = *(const f32x4*)(sn + (size_t)row * 16 + 4 * fq);
                        const f32x4 a = v0 * rn * g1, b = v1 * rn * g2;
                        *(u32x4*)(kpe + (size_t)row * 32 + 8 * fq) = pack8(a * c - b * s, b * c + a * s);
                    }
                    *(u32x4*)(z + (size_t)row * INP + colb + bj * 128) = pack8(v0, v1);
                }
            }
    }
};
struct EpiQ {
    bf16_t* Q; const float* zs; const float* gn; const float* gr; const float* cs; const float* sn;
    __device__ __forceinline__ void operator()(const f32x4 (&acc)[2][2][4][2], const Unit& u, int wr, int wc, int fr, int fq) const {
        float rs8[2][4]; rstd8(rs8, zs, u.pm * 256 + wr * 64 + fr, 32, fq, 3, 1.0f / 384.0f);
#pragma unroll
        for (int ai = 0; ai < 2; ++ai)
#pragma unroll
            for (int m = 0; m < 4; ++m) {
                const int row = u.pm * 256 + ai * 128 + wr * 64 + m * 16 + fr;
                const float rs = rs8[ai][m];
                if (u.pn < 2) {
                    const int h = 4 * u.pn + wc;
                    f32x4 v[2][2]; float ss = 0.f;
#pragma unroll
                    for (int bj = 0; bj < 2; ++bj)
#pragma unroll
                        for (int n = 0; n < 2; ++n) { v[bj][n] = acc[ai][bj][m][n] * rs; ss += dot4(v[bj][n]); }
                    const float rn = rsqrtf(fq_sum(ss) * (1.0f / 64.0f) + EPS) * QSCALE;
#pragma unroll
                    for (int bj = 0; bj < 2; ++bj) {
                        const f32x4 g0 = *(const f32x4*)(gn + 32 * bj + 8 * fq), g1 = *(const f32x4*)(gn + 32 * bj + 8 * fq + 4);
                        *(u32x4*)(Q + (size_t)row * 768 + h * 96 + 32 * bj + 8 * fq) = pack8(v[bj][0] * rn * g0, v[bj][1] * rn * g1);
                    }
                } else {
                    const f32x4 c = *(const f32x4*)(cs + (size_t)row * 16 + 4 * fq), s = *(const f32x4*)(sn + (size_t)row * 16 + 4 * fq);
                    const f32x4 g1 = *(const f32x4*)(gr + 4 * fq), g2 = *(const f32x4*)(gr + 16 + 4 * fq);
#pragma unroll
                    for (int bj = 0; bj < 2; ++bj) {
                        const int h = 4 * bj + wc;
                        const f32x4 v0 = acc[ai][bj][m][0] * rs, v1 = acc[ai][bj][m][1] * rs;
                        const float rn = rsqrtf(fq_sum(dot4(v0) + dot4(v1)) * (1.0f / 32.0f) + EPS);
                        const f32x4 a = v0 * rn * g1, b = v1 * rn * g2;
                        *(u32x4*)(Q + (size_t)row * 768 + h * 96 + 64 + 8 * fq) = pack8((a * c - b * s) * QSCALE, (b * c + a * s) * QSCALE);
                    }
                }
            }
    }
};
struct EpiKV {
    bf16_t* Kn; bf16_t* V; const float* zs; const float* gn;
    __device__ __forceinline__ void operator()(const f32x4 (&acc)[2][2][4][2], const Unit& u, int wr, int wc, int fr, int fq) const {
        float rs8[2][4]; rstd8(rs8, zs + 16, u.pm * 256 + wr * 64 + fr, 32, fq, 2, 1.0f / 256.0f);
#pragma unroll
        for (int ai = 0; ai < 2; ++ai)
#pragma unroll
            for (int m = 0; m < 4; ++m) {
                const int row = u.pm * 256 + ai * 128 + wr * 64 + m * 16 + fr;
                const float rs = rs8[ai][m];
                if (u.pn < 2) {
                    const int h = 4 * u.pn + wc;
                    f32x4 v[2][2]; float ss = 0.f;
#pragma unroll
                    for (int bj = 0; bj < 2; ++bj)
#pragma unroll
                        for (int n = 0; n < 2; ++n) { v[bj][n] = acc[ai][bj][m][n] * rs; ss += dot4(v[bj][n]); }
                    const float rn = rsqrtf(fq_sum(ss) * (1.0f / 64.0f) + EPS);
#pragma unroll
                    for (int bj = 0; bj < 2; ++bj) {
                        const f32x4 g0 = *(const f32x4*)(gn + 32 * bj + 8 * fq), g1 = *(const f32x4*)(gn + 32 * bj + 8 * fq + 4);
                        *(u32x4*)(Kn + (size_t)row * 512 + h * 64 + 32 * bj + 8 * fq) = pack8(v[bj][0] * rn * g0, v[bj][1] * rn * g1);
                    }
                } else {
#pragma unroll
                    for (int bj = 0; bj < 2; ++bj)
                        *(u32x4*)(V + (size_t)row * 512 + (u.pn - 2) * 256 + bj * 128 + wc * 32 + 8 * fq) = pack8(acc[ai][bj][m][0] * rs, acc[ai][bj][m][1] * rs);
                }
            }
    }
};
struct EpiUp {
    bf16_t* H;
    __device__ __forceinline__ void operator()(const f32x4 (&acc)[2][2][4][2], const Unit& u, int wr, int wc, int fr, int fq) const {
        const int colb = u.pn * 256 + wc * 32 + 8 * fq;
#pragma unroll
        for (int ai = 0; ai < 2; ++ai)
#pragma unroll
            for (int m = 0; m < 4; ++m) {
                const int row = u.pm * 256 + ai * 128 + wr * 64 + m * 16 + fr;
#pragma unroll
                for (int bj = 0; bj < 2; ++bj) {
                    f32x4 v0 = acc[ai][bj][m][0], v1 = acc[ai][bj][m][1];
#pragma unroll
                    for (int i = 0; i < 4; ++i) { const float a = fmaxf(v0[i], 0.f), b = fmaxf(v1[i], 0.f); v0[i] = a * a; v1[i] = b * b; }
                    *(u32x4*)(H + (size_t)row * FF + colb + bj * 128) = pack8(v0, v1);
                }
            }
    }
};
struct EpiPg {
    bf16_t* pg;
    __device__ __forceinline__ void operator()(const f32x4 (&acc)[2][2][4][2], const Unit& u, int wr, int wc, int fr, int fq) const {
        const int colb = u.pn * 256 + wc * 32 + 8 * fq;
#pragma unroll
        for (int ai = 0; ai < 2; ++ai)
#pragma unroll
            for (int m = 0; m < 4; ++m) {
                const int row = u.pm * 256 + ai * 128 + wr * 64 + m * 16 + fr;
#pragma unroll
                for (int bj = 0; bj < 2; ++bj) *(u32x4*)(pg + (size_t)row * 1024 + colb + bj * 128) = pack8(acc[ai][bj][m][0], acc[ai][bj][m][1]);
            }
    }
};
template <int MODE, bool LAST> struct EpiRes {
    const bf16_t* xold; bf16_t* xb; float* xout; float* xs_out; const float* xs_in; const bf16_t* pg; const float* ass;
    __device__ __forceinline__ void mid(f32x4 (&acc)[2][2][4][2], const Unit& u, int wr, int wc, int fr, int fq) const {
        f32x4 p[2][4];
        int rowb = u.pm * 256 + wr * 64 + fr; asm volatile("" : "+v"(rowb));
#pragma unroll
        for (int ai = 0; ai < 2; ++ai)
#pragma unroll
            for (int m = 0; m < 4; ++m) p[ai][m] = *(const f32x4*)(ass + (size_t)(rowb + ai * 128 + m * 16) * 8 + (fq & 1) * 4);
#pragma unroll
        for (int ai = 0; ai < 2; ++ai)
#pragma unroll
            for (int m = 0; m < 4; ++m) {
                float sq = (p[ai][m][0] + p[ai][m][1]) + (p[ai][m][2] + p[ai][m][3]); sq += __shfl_xor(sq, 16);
                const float rs = rsqrtf(sq * (1.0f / 512.0f) + EPS);
#pragma unroll
                for (int bj = 0; bj < 2; ++bj)
#pragma unroll
                    for (int n = 0; n < 2; ++n) acc[ai][bj][m][n] = acc[ai][bj][m][n] * rs;
            }
    }
    __device__ __forceinline__ void operator()(const f32x4 (&acc)[2][2][4][2], const Unit& u, int wr, int wc, int fr, int fq) const {
        const int colb = u.pn * 256 + wc * 32 + 8 * fq;
        float rs8[2][4];
        if (MODE != 0) rstd8(rs8, xs_in, u.pm * 256 + wr * 64 + fr, 16, fq, 4, 1.0f / 1024.0f);
        constexpr int NB = (MODE == 1) ? 2 : 4;
#pragma unroll
        for (int g = 0; g < 8 / NB; ++g) {
            u32x4 xw[NB][2], pw[NB][2];
#pragma unroll
            for (int k = 0; k < NB; ++k)
#pragma unroll
                for (int bj = 0; bj < 2; ++bj) {
                    const int ai = (g * NB + k) >> 2, m = (g * NB + k) & 3;
                    const size_t off = (size_t)(u.pm * 256 + ai * 128 + wr * 64 + m * 16 + fr) * 1024 + colb + bj * 128;
                    xw[k][bj] = *(const u32x4*)(xold + off);
                    if (MODE == 1) pw[k][bj] = *(const u32x4*)(pg + off);
                }
#pragma unroll
            for (int k = 0; k < NB; ++k) {
                const int ai = (g * NB + k) >> 2, m = (g * NB + k) & 3;
                const int row = u.pm * 256 + ai * 128 + wr * 64 + m * 16 + fr;
                float ss = 0.f;
#pragma unroll
                for (int bj = 0; bj < 2; ++bj) {
                    const size_t off = (size_t)row * 1024 + colb + bj * 128;
                    const u32x4 w = xw[k][bj];
                    const f32x4 x0 = (f32x4){bf_lo(w.x), bf_hi(w.x), bf_lo(w.y), bf_hi(w.y)}, x1 = (f32x4){bf_lo(w.z), bf_hi(w.z), bf_lo(w.w), bf_hi(w.w)};
                    f32x4 d0 = acc[ai][bj][m][0], d1 = acc[ai][bj][m][1];
                    if (MODE == 2) { const float r2 = rs8[ai][m] * rs8[ai][m]; d0 = d0 * r2; d1 = d1 * r2; }
                    if (MODE == 1) {
                        const float rs = rs8[ai][m];
                        const u32x4 q = pw[k][bj];
                        const f32x4 p0 = (f32x4){bf_lo(q.x), bf_hi(q.x), bf_lo(q.y), bf_hi(q.y)}, p1 = (f32x4){bf_lo(q.z), bf_hi(q.z), bf_lo(q.w), bf_hi(q.w)};
#pragma unroll
                        for (int i = 0; i < 4; ++i) { d0[i] = p0[i] * __builtin_amdgcn_rcpf(1.0f + __expf(-d0[i] * rs)); d1[i] = p1[i] * __builtin_amdgcn_rcpf(1.0f + __expf(-d1[i] * rs)); }
                    }
                    const f32x4 y0 = x0 + d0, y1 = x1 + d1;
                    if (LAST) { *(f32x4*)(xout + off) = y0; *(f32x4*)(xout + off + 4) = y1; }
                    else { ss += dot4(y0) + dot4(y1); *(u32x4*)(xb + off) = pack8(y0, y1); }
                }
                if (!LAST) { ss = fq_sum(ss); if (fq == 0) xs_out[(size_t)row * 16 + u.pn * 4 + wc] = ss; }
            }
            asm volatile("" ::: "memory");
        }
    }
};
}

namespace attn {
using bf16 = __hip_bfloat16;
using s16x4 = __attribute__((ext_vector_type(4))) short;
using f32x16 = __attribute__((ext_vector_type(16))) float;
constexpr int NW = 8, QBLK = 32, QB = 256, KVBLK = 64, NQB = SEQ / QB;
constexpr int QP = 768, KNP = 512, KPP = 32, VP = 512, OP = 1024;
constexpr int KSLOT = 12288, VSLOT = 8192, NSLOT = 3;
constexpr int LDS_K = 0, LDS_V = 4 * KSLOT, LDS_WS = LDS_V + 5 * VSLOT, LDS_OST = LDS_WS + NW * 256, LDS_TOTAL = LDS_OST + NW * 4096;
static_assert(LDS_TOTAL <= 131072, "attention LDS");
__device__ __forceinline__ int crow(int r, int hi) { return (r & 3) + 8 * (r >> 2) + 4 * hi; }
#define SBAR() __builtin_amdgcn_sched_barrier(0)
__device__ __forceinline__ void cmask(f32x16& p0, f32x16& p1, int jb, int qrel, int hi) {
    const float NEG = -INFINITY; const int kb = 64 * jb + 4 * hi;
#pragma unroll
    for (int r = 0; r < 16; ++r) { const int kv = kb + (r & 3) + 8 * (r >> 2); if (kv > qrel) p0[r] = NEG; if (kv + 32 > qrel) p1[r] = NEG; }
}
__device__ __forceinline__ void glds16(const void* gsrc, unsigned lds_dst) { unsigned keep;
    asm volatile("s_mov_b32 %0, m0\n\ts_mov_b32 m0, %2\n\ts_nop 0\n\tglobal_load_lds_dwordx4 %1, off\n\ts_mov_b32 m0, %0" : "=&s"(keep) : "v"(gsrc), "s"(lds_dst) : "memory"); }
__device__ __forceinline__ float max3f(float a, float b, float c) { return __builtin_fmaxf(__builtin_fmaxf(a, b), c); }
__device__ __forceinline__ float rowmax(const f32x16& p0, const f32x16& p1) {
    float a = max3f(p0[0], p0[1], p1[0]), b = max3f(p0[2], p0[3], p1[1]); a = max3f(a, p1[2], p1[3]);
#pragma unroll
    for (int r = 4; r < 16; r += 4) { a = max3f(a, p0[r], p0[r + 1]); b = max3f(b, p0[r + 2], p0[r + 3]); a = max3f(a, p1[r], p1[r + 1]); b = max3f(b, p1[r + 2], p1[r + 3]); }
    const float m = __builtin_fmaxf(a, b);
    auto rr = __builtin_amdgcn_permlane32_swap(__float_as_uint(m), __float_as_uint(m), false, false);
    return __builtin_fmaxf(__uint_as_float(rr[0]), __uint_as_float(rr[1]));
}
#define WAIT_BAR(N) asm volatile("s_waitcnt vmcnt(" #N ") lgkmcnt(0)\n\ts_barrier" ::: "memory")
__device__ __forceinline__ void qkt(f32x16& p0, f32x16& p1, const LAS char* Kslot, const bf16x8* qr, int r32, int hi) {
    const LAS char* kb = Kslot + hi * 1024 + r32 * 16;
    const f32x16 zero = f32x16{};
#pragma unroll
    for (int d0 = 0; d0 < 6; ++d0) {
        const bf16x8 b0 = *(const LAS bf16x8*)(kb + d0 * 2048);
        const bf16x8 b1 = *(const LAS bf16x8*)(kb + d0 * 2048 + 512);
        if (d0 == 0) { p0 = __builtin_amdgcn_mfma_f32_32x32x16_bf16(b0, qr[0], zero, 0, 0, 0); p1 = __builtin_amdgcn_mfma_f32_32x32x16_bf16(b1, qr[0], zero, 0, 0, 0); }
        else { p0 = __builtin_amdgcn_mfma_f32_32x32x16_bf16(b0, qr[d0], p0, 0, 0, 0); p1 = __builtin_amdgcn_mfma_f32_32x32x16_bf16(b1, qr[d0], p1, 0, 0, 0); }
    }
}
__device__ __forceinline__ void pv(f32x16* o, int vb, bf16x8 pa0, bf16x8 pa1, bf16x8 pa2, bf16x8 pa3) {
#pragma unroll
    for (int d0 = 0; d0 < 2; ++d0) { s16x4 lo[4], hi[4];
#pragma unroll
        for (int ks = 0; ks < 4; ++ks) {
            asm volatile("ds_read_b64_tr_b16 %0,%1 offset:%c2" : "=&v"(lo[ks]) : "v"(vb), "i"(d0 * 4096 + ks * 1024) : "memory");
            asm volatile("ds_read_b64_tr_b16 %0,%1 offset:%c2" : "=&v"(hi[ks]) : "v"(vb), "i"(d0 * 4096 + ks * 1024 + 512) : "memory"); }
        asm volatile("s_waitcnt lgkmcnt(0)" ::: "memory"); SBAR();
#define PK(k) (bf16x8){lo[k][0], lo[k][1], lo[k][2], lo[k][3], hi[k][0], hi[k][1], hi[k][2], hi[k][3]}
        o[d0] = __builtin_amdgcn_mfma_f32_32x32x16_bf16(pa0, PK(0), o[d0], 0, 0, 0);
        o[d0] = __builtin_amdgcn_mfma_f32_32x32x16_bf16(pa1, PK(1), o[d0], 0, 0, 0);
        o[d0] = __builtin_amdgcn_mfma_f32_32x32x16_bf16(pa2, PK(2), o[d0], 0, 0, 0);
        o[d0] = __builtin_amdgcn_mfma_f32_32x32x16_bf16(pa3, PK(3), o[d0], 0, 0, 0);
#undef PK
    }
}
typedef short v4i16_t __attribute__((ext_vector_type(4)));
__device__ __forceinline__ s16x4 vtr(const LAS char* p) { return __builtin_bit_cast(s16x4, __builtin_amdgcn_ds_read_tr16_b64_v4i16((LAS v4i16_t*)p)); }
__device__ __forceinline__ unsigned cvtpk_s(float lo, float hi) { f32x2 v = {lo, hi}; typedef __bf16 bf16x2_t __attribute__((ext_vector_type(2))); bf16x2_t b = __builtin_convertvector(v, bf16x2_t); return __builtin_bit_cast(unsigned, b); }

__device__ __forceinline__ void attn_unit(int b, int h, int qb, const bf16* Q, const bf16* __restrict__ Kn, const bf16* __restrict__ Kpe, const bf16* __restrict__ V, bf16* O, float* ASS, LAS char* shm) {
    int tid_ = threadIdx.x; asm volatile("" : "+v"(tid_));
    const int tid = tid_, lane = tid & 63, r32 = lane & 31, hi = lane >> 5; const int wid = __builtin_amdgcn_readfirstlane(tid >> 6);
    const long rowbase = (long)b * SEQ; const int q0 = qb * QB;
    const bf16* Qw = Q + (rowbase + q0 + wid * QBLK) * QP + h * 96;
    const unsigned lds0 = (unsigned)(uintptr_t)shm;
    LAS float* wsf = (LAS float*)(shm + LDS_WS) + wid * 64;
    const bf16* ksrc = Kn + (rowbase + lane) * KNP + h * 64 + wid * 8;
    const bf16* k2src = Kpe + (rowbase + lane) * KPP + (wid & 3) * 8;
    const bf16* vsrc = V + (rowbase + 16 * (wid & 3) + (lane >> 2)) * VP + h * 64 + (wid >> 2) * 32 + (lane & 3) * 8;
    const unsigned kdst = lds0 + LDS_K + wid * 1024, k2dst = lds0 + LDS_K + (8 + (wid & 3)) * 1024, vdst = lds0 + LDS_V + wid * 1024;
#define DMA_TILE(t, ks, vs) do { glds16(ksrc + (long)(t) * KVBLK * KNP, (unsigned)__builtin_amdgcn_readfirstlane(kdst + (ks) * KSLOT)); \
        glds16(k2src + (long)(t) * KVBLK * KPP, (unsigned)__builtin_amdgcn_readfirstlane(k2dst + (ks) * KSLOT)); \
        glds16(vsrc + (long)(t) * KVBLK * VP, (unsigned)__builtin_amdgcn_readfirstlane(vdst + (vs) * VSLOT)); } while (0)
    const int vb0 = (int)(lds0 + LDS_V) + ((lane >> 4) & 1) * 32 + (lane & 3) * 8 + (4 * hi + ((lane & 15) >> 2)) * 64;
    const int NT = (q0 + QB) / KVBLK;
    DMA_TILE(0, 0, 0); DMA_TILE(1, 1, 1); DMA_TILE(2, 2, 2);
    bf16x8 qr[6];
#pragma unroll
    for (int d0 = 0; d0 < 6; ++d0) qr[d0] = *reinterpret_cast<const bf16x8*>(&Qw[(long)r32 * QP + d0 * 16 + hi * 8]);
    asm volatile("" : "+v"(qr[0]), "+v"(qr[1]), "+v"(qr[2]), "+v"(qr[3]), "+v"(qr[4]), "+v"(qr[5]));
    float m_run = -1e30f, l_run = 0.f; f32x16 o[2]; o[0] = f32x16{}; o[1] = f32x16{};
    const int qrel = wid * QBLK + r32;
    f32x16 p0, p1;
    bf16x8 kf[12]; s16x4 vlo[8], vhi[8]; u32x4 pw0, pw1, pw2, pw3;
    const LAS char* kp0 = shm + LDS_K + hi * 1024 + r32 * 16;
    const LAS char* vp0 = shm + LDS_V + ((lane >> 4) & 1) * 32 + (lane & 3) * 8 + (4 * hi + ((lane & 15) >> 2)) * 64;
#define K_LOAD(ks) do { const LAS char* kp_ = kp0 + (ks) * KSLOT; \
        _Pragma("unroll") for (int i_ = 0; i_ < 6; ++i_) { kf[2 * i_] = *(const LAS bf16x8*)(kp_ + i_ * 2048); kf[2 * i_ + 1] = *(const LAS bf16x8*)(kp_ + i_ * 2048 + 512); } SBAR(); } while (0)
#define V_LOAD(vs) do { const LAS char* vp_ = vp0 + (vs) * VSLOT; \
        _Pragma("unroll") for (int i_ = 0; i_ < 8; ++i_) { vlo[i_] = vtr(vp_ + ((i_ >> 2) * 4096 + (i_ & 3) * 1024)); vhi[i_] = vtr(vp_ + ((i_ >> 2) * 4096 + (i_ & 3) * 1024 + 512)); } SBAR(); } while (0)
#define QK_MMA(t) do { const f32x16 zero_ = f32x16{}; \
        p0 = __builtin_amdgcn_mfma_f32_32x32x16_bf16(kf[0], qr[0], zero_, 0, 0, 0); p1 = __builtin_amdgcn_mfma_f32_32x32x16_bf16(kf[1], qr[0], zero_, 0, 0, 0); \
        _Pragma("unroll") for (int i_ = 1; i_ < 6; ++i_) { p0 = __builtin_amdgcn_mfma_f32_32x32x16_bf16(kf[2 * i_], qr[i_], p0, 0, 0, 0); p1 = __builtin_amdgcn_mfma_f32_32x32x16_bf16(kf[2 * i_ + 1], qr[i_], p1, 0, 0, 0); } \
        if ((t) >= NT - 4) cmask(p0, p1, (t) - (NT - 4), qrel, hi); SBAR(); } while (0)
#define SOFTMAX() do { \
        const float rm = rowmax(p0, p1); \
        if (__builtin_expect(__any(rm > m_run + 8.0f), 0)) { \
            const float mn = __builtin_fmaxf(m_run, rm); const float alpha = __builtin_amdgcn_exp2f(m_run - mn); \
            l_run *= alpha; m_run = mn; if (hi == 0) wsf[r32] = alpha; \
            asm volatile("s_waitcnt lgkmcnt(0)" ::: "memory"); \
            _Pragma("unroll") for (int r = 0; r < 16; ++r) { const float f = wsf[crow(r, hi)]; o[0][r] *= f; o[1][r] *= f; } \
        } \
        float sacc = 0.f; \
        _Pragma("unroll") for (int r = 0; r < 16; ++r) { p0[r] = __builtin_amdgcn_exp2f(p0[r] - m_run); p1[r] = __builtin_amdgcn_exp2f(p1[r] - m_run); sacc += p0[r] + p1[r]; } \
        l_run += sacc; \
        pw0 = (u32x4){cvtpk_s(p0[0], p0[1]), cvtpk_s(p0[2], p0[3]), cvtpk_s(p0[4], p0[5]), cvtpk_s(p0[6], p0[7])}; \
        pw1 = (u32x4){cvtpk_s(p0[8], p0[9]), cvtpk_s(p0[10], p0[11]), cvtpk_s(p0[12], p0[13]), cvtpk_s(p0[14], p0[15])}; \
        pw2 = (u32x4){cvtpk_s(p1[0], p1[1]), cvtpk_s(p1[2], p1[3]), cvtpk_s(p1[4], p1[5]), cvtpk_s(p1[6], p1[7])}; \
        pw3 = (u32x4){cvtpk_s(p1[8], p1[9]), cvtpk_s(p1[10], p1[11]), cvtpk_s(p1[12], p1[13]), cvtpk_s(p1[14], p1[15])}; \
        SBAR(); } while (0)
#define VFR(i) (bf16x8){vlo[i][0], vlo[i][1], vlo[i][2], vlo[i][3], vhi[i][0], vhi[i][1], vhi[i][2], vhi[i][3]}
#define PAF(k) __builtin_bit_cast(bf16x8, pw##k)
#define PV_MMA() do { \
        o[0] = __builtin_amdgcn_mfma_f32_32x32x16_bf16(PAF(0), VFR(0), o[0], 0, 0, 0); o[1] = __builtin_amdgcn_mfma_f32_32x32x16_bf16(PAF(0), VFR(4), o[1], 0, 0, 0); \
        o[0] = __builtin_amdgcn_mfma_f32_32x32x16_bf16(PAF(1), VFR(1), o[0], 0, 0, 0); o[1] = __builtin_amdgcn_mfma_f32_32x32x16_bf16(PAF(1), VFR(5), o[1], 0, 0, 0); \
        o[0] = __builtin_amdgcn_mfma_f32_32x32x16_bf16(PAF(2), VFR(2), o[0], 0, 0, 0); o[1] = __builtin_amdgcn_mfma_f32_32x32x16_bf16(PAF(2), VFR(6), o[1], 0, 0, 0); \
        o[0] = __builtin_amdgcn_mfma_f32_32x32x16_bf16(PAF(3), VFR(3), o[0], 0, 0, 0); o[1] = __builtin_amdgcn_mfma_f32_32x32x16_bf16(PAF(3), VFR(7), o[1], 0, 0, 0); \
        SBAR(); } while (0)
    int ks = 0, vs = 0;
#define WAIT_TILE(t) do { if ((t) + 2 < NT) { WAIT_BAR(6); } else if ((t) + 1 < NT) { WAIT_BAR(3); } else { WAIT_BAR(0); } } while (0)
#define VS_ADD(v, k) (((v) + (k) >= 5) ? (v) + (k) - 5 : (v) + (k))
    if (wid < 4) {
        for (int t = 0; t < NT; ++t) {
            WAIT_TILE(t);
            K_LOAD(ks);
            if (t + 3 < NT) DMA_TILE(t + 3, (ks + 3) & 3, VS_ADD(vs, 3));
            SBAR();
            QK_MMA(t);
            V_LOAD(vs);
            SOFTMAX();
            PV_MMA();
            ks = (ks + 1) & 3; vs = VS_ADD(vs, 1);
        }
    } else {
        for (int t = 0; t < NT; ++t) {
            WAIT_TILE(t);
            if (t > 0) V_LOAD(VS_ADD(vs, 4));
            if (t + 3 < NT) DMA_TILE(t + 3, (ks + 3) & 3, VS_ADD(vs, 3));
            SBAR();
            if (t > 0) SOFTMAX();
            K_LOAD(ks);
            if (t > 0) PV_MMA();
            QK_MMA(t);
            ks = (ks + 1) & 3; vs = VS_ADD(vs, 1);
        }
        V_LOAD(VS_ADD(vs, 4));
        SOFTMAX();
        PV_MMA();
    }
#undef WAIT_TILE
#undef VS_ADD
#undef K_LOAD
#undef V_LOAD
#undef QK_MMA
#undef SOFTMAX
#undef VFR
#undef PAF
#undef PV_MMA
    { auto rr = __builtin_amdgcn_permlane32_swap(__float_as_uint(l_run), __float_as_uint(l_run), false, false); l_run = __uint_as_float(rr[0]) + __uint_as_float(rr[1]); }
    if (hi == 0) wsf[32 + r32] = l_run; asm volatile("s_waitcnt lgkmcnt(0)" ::: "memory");
    float rli[16];
#pragma unroll
    for (int r = 0; r < 16; ++r) rli[r] = __builtin_amdgcn_rcpf(wsf[32 + crow(r, hi)]);
    bf16* Ow = O + (rowbase + q0 + wid * QBLK) * OP + h * 64;
    { LAS unsigned short* stg = (LAS unsigned short*)(shm + LDS_OST) + wid * 2048;
#pragma unroll
      for (int r = 0; r < 16; ++r) { const int orow = crow(r, hi);
#pragma unroll
          for (int d0 = 0; d0 < 2; ++d0) stg[orow * 64 + d0 * 32 + r32] = (unsigned short)(cvtpk_s(o[d0][r] * rli[r], 0.f) & 0xffffu); }
      asm volatile("s_waitcnt lgkmcnt(0)" ::: "memory");
#pragma unroll
      for (int i = 0; i < 4; ++i) { const int row = i * 8 + (lane >> 3), ch = lane & 7; const u32x4 v = *(const LAS u32x4*)(stg + row * 64 + ch * 8); *(u32x4*)(Ow + (long)row * OP + ch * 8) = v;
          float sq = 0.f;
#pragma unroll
          for (int k = 0; k < 4; ++k) { const float a = __uint_as_float(v[k] << 16), bq = __uint_as_float(v[k] & 0xffff0000u); sq += a * a + bq * bq; }
          sq += __shfl_xor(sq, 1); sq += __shfl_xor(sq, 2); sq += __shfl_xor(sq, 4);
          if (ch == 0) ASS[(rowbase + q0 + wid * QBLK + row) * 8 + h] = sq; } }
    asm volatile("s_waitcnt lgkmcnt(0)\n\ts_barrier" ::: "memory");
#undef DMA_TILE
}
#undef SBAR
#undef WAIT_BAR
}

#define XB_TMO      128
#define XB_XCNT(j)  (256  + 64 * (j))
#define XB_XSUB(j)  (1280 + 64 * (j))
#define XB_XGEN(j)  (2304 + 64 * (j))
#define XB_TOP      3328
#define XB_TOPGEN   3392
#define XCD_BAR_WORDS 3456
#define XB_LSUB(j)  (3456 + 64 * (j))
#define XB_LGEN(j)  (4480 + 64 * (j))
#define XB_SPIN_CAP (1u << 22)
__device__ __forceinline__ unsigned xb_ld(unsigned* p)              { return __hip_atomic_load(p, __ATOMIC_RELAXED, __HIP_MEMORY_SCOPE_AGENT); }
__device__ __forceinline__ unsigned xb_add(unsigned* p, unsigned v) { return __hip_atomic_fetch_add(p, v, __ATOMIC_RELAXED, __HIP_MEMORY_SCOPE_AGENT); }
__device__ __forceinline__ unsigned xb_xcc_id() { return (unsigned)__builtin_amdgcn_s_getreg((3 << 11) | 20) & 0xFu; }
#define XB_SPIN(cond, bar) do { unsigned _sp = 0; while (cond) { __builtin_amdgcn_s_sleep(1); \
    if ((++_sp & 255u) == 0u) { if (xb_ld(&(bar)[XB_TMO])) break; if (_sp > XB_SPIN_CAP) { atomicAdd(&(bar)[XB_TMO], 1u); break; } } } } while (0)
struct XcdBarrier { unsigned* bar; unsigned x; volatile LAS unsigned* st; };
__device__ __forceinline__ XcdBarrier xcd_barrier_post(unsigned* bar, volatile LAS unsigned* st) {
    XcdBarrier b; b.bar = bar; b.x = xb_xcc_id(); b.st = st;
    if (threadIdx.x == 0) st[10] = xb_add(&bar[XB_XCNT(b.x)], 1u);
    return b;
}
__device__ __forceinline__ void xcd_barrier_complete(unsigned* bar, unsigned x, unsigned& nloc, unsigned& nx) {
    const unsigned G = gridDim.x * gridDim.y * gridDim.z;
    unsigned sum, cnt, mine, sp = 0u;
    for (;;) {
        sum = 0u; cnt = 0u; mine = 0u;
#pragma unroll
        for (unsigned j = 0; j < 16; ++j) { const unsigned c = xb_ld(&bar[XB_XCNT(j)]); sum += c; cnt += (c > 0u) ? 1u : 0u; mine = (j == x) ? c : mine; }
        if (sum == G) break;
        __builtin_amdgcn_s_sleep(1);
        if ((++sp & 255u) == 0u) { if (xb_ld(&bar[XB_TMO])) break; if (sp > XB_SPIN_CAP) { atomicAdd(&bar[XB_TMO], 1u); break; } }
    }
    nloc = mine > 0u ? mine : 1u; nx = cnt > 0u ? cnt : 1u;
}
__device__ __forceinline__ void xcd_barrier(const XcdBarrier& b) {
    asm volatile("s_waitcnt vmcnt(0)" ::: "memory");
    __syncthreads();
    if (threadIdx.x == 0) {
        unsigned* bar = b.bar;
        __builtin_amdgcn_s_waitcnt(0);
        unsigned nloc = b.st[0], nx = b.st[1];
        if (nloc == 0u) { xcd_barrier_complete(bar, b.x, nloc, nx); b.st[0] = nloc; b.st[1] = nx; }
        const unsigned old = xb_add(&bar[XB_XSUB(b.x)], 1u);
        const unsigned gen = old / nloc;
        if (old + 1u == (gen + 1u) * nloc) {
            __builtin_amdgcn_fence(__ATOMIC_RELEASE, "agent");
            asm volatile("s_waitcnt vmcnt(0)" ::: "memory");
            const unsigned og = xb_add(&bar[XB_TOP], 1u);
            const unsigned tg = og / nx;
            if (og + 1u == (tg + 1u) * nx) xb_add(&bar[XB_TOPGEN], 1u);
            else XB_SPIN(xb_ld(&bar[XB_TOPGEN]) == tg, bar);
            __builtin_amdgcn_fence(__ATOMIC_ACQUIRE, "agent");
            xb_add(&bar[XB_XGEN(b.x)], 1u);
            asm volatile("s_waitcnt vmcnt(0)" ::: "memory");
        } else {
            XB_SPIN(xb_ld(&bar[XB_XGEN(b.x)]) == gen, bar);
            __builtin_amdgcn_fence(__ATOMIC_ACQUIRE, "agent");
            asm volatile("s_waitcnt vmcnt(0)" ::: "memory");
        }
    }
    __syncthreads();
}

__device__ __forceinline__ void xcd_local_barrier(const XcdBarrier& b, unsigned nloc) {
    asm volatile("s_waitcnt vmcnt(0)" ::: "memory");
    __syncthreads();
    if (threadIdx.x == 0) {
        unsigned* bar = b.bar;
        __builtin_amdgcn_s_waitcnt(0);
        const unsigned old = xb_add(&bar[XB_LSUB(b.x)], 1u);
        const unsigned gen = old / nloc;
        if (old + 1u == (gen + 1u) * nloc) xb_add(&bar[XB_LGEN(b.x)], 1u);
        else XB_SPIN(xb_ld(&bar[XB_LGEN(b.x)]) == gen, bar);
        __builtin_amdgcn_fence(__ATOMIC_ACQUIRE, "agent");
        asm volatile("s_waitcnt vmcnt(0)" ::: "memory");
    }
    __syncthreads();
}

struct Args { const void* in[23]; float* out; unsigned char* ws; };

__device__ __forceinline__ int ropeL(int p) { return ((p >> 2) & 1) * 16 + (p >> 3) * 4 + (p & 3); }
__device__ __forceinline__ int colmap(int id, int n) {
    if (id == 0) { if (n < 640) return n; if (n < 672) return 640 + ropeL(n - 640); if (n < 768) return -1; if (n < 1280) return n - 96;
                   const int q = n - 1280, T = q >> 8, bj = (q >> 7) & 1, j = q & 127; return (bj ? 1696 : 1184) + 128 * T + j; }
    if (id == 1) { const int pn = n >> 8, bj = (n >> 7) & 1, wc = (n >> 5) & 3, j = n & 31; if (pn < 2) return (4 * pn + wc) * 96 + 32 * bj + j; return (4 * bj + wc) * 96 + 64 + ropeL(j); }
    if (id == 2) { if (n < 512) { const int pn = n >> 8, bj = (n >> 7) & 1, wc = (n >> 5) & 3, j = n & 31; return (4 * pn + wc) * 128 + 32 * bj + j; } const int mm = n - 512; return (mm >> 6) * 128 + 64 + (mm & 63); }
    return n;
}
__device__ __forceinline__ void wconv_item(const float* W, int K, int Norig, int Nphys, bf16_t* WT, const float* gA, const float* gB, int split, int mapid, LAS float* scr, int item, int lane) {
    const int nblk = Nphys / 32, kb = item / nblk, nb = item % nblk, k0 = 64 * kb, n0 = 32 * nb;
    const int norig = colmap(mapid, n0 + (lane & 31));
    float wv[32];
#pragma unroll
    for (int i = 0; i < 32; ++i) { const int k = k0 + 2 * i + (lane >> 5); wv[i] = (norig >= 0) ? W[(size_t)k * Norig + norig] : 0.f; }
#pragma unroll
    for (int i = 0; i < 32; ++i) { const int kk = 2 * i + (lane >> 5), k = k0 + kk;
        float v = wv[i];
        if (gA) v *= (k < split ? gA[k] : gB[k - split]);
        scr[kk * 33 + (lane & 31)] = v; }
    asm volatile("s_waitcnt lgkmcnt(0)" ::: "memory");
    const int c = lane & 7;
#pragma unroll
    for (int j = 0; j < 4; ++j) { const int n = (lane >> 3) + 8 * j; const LAS float* s = scr + (8 * c) * 33 + n;
        u32x4 o; o.x = cvt_pk_bf16(s[0 * 33], s[1 * 33]); o.y = cvt_pk_bf16(s[2 * 33], s[3 * 33]); o.z = cvt_pk_bf16(s[4 * 33], s[5 * 33]); o.w = cvt_pk_bf16(s[6 * 33], s[7 * 33]);
        *(u32x4*)(WT + (size_t)(n0 + n) * K + k0 + 8 * c) = o; }
    asm volatile("s_waitcnt lgkmcnt(0)" ::: "memory");
}
template <class AP> __device__ __forceinline__ void convert_weights(AP a, int L, bf16_t* wb, LAS float* scr, int gw, int NGW, int lane) {
    constexpr int I0 = 16 * 72, I1 = 6 * 24, I2 = 4 * 32, I3 = 16 * 32, I4 = 16 * 128, I5 = 64 * 32, I6 = 16 * 32, I7 = 4 * 32;
    constexpr int NIT = I0 + I1 + I2 + I3 + I4 + I5 + I6 + I7;
    const float* g_mix = (const float*)a->in[3] + L * 1024; const float* w_in = (const float*)a->in[4] + (size_t)L * 1024 * INC;
    const float* g_ql = (const float*)a->in[5] + L * QL; const float* w_uq = (const float*)a->in[6] + (size_t)L * QL * 768;
    const float* g_kvl = (const float*)a->in[7] + L * KVL; const float* w_ukv = (const float*)a->in[8] + (size_t)L * KVL * 1024;
    const float* g_oa = (const float*)a->in[14] + L * 512; const float* g_oc = (const float*)a->in[15] + L * 512; const float* w_o = (const float*)a->in[16] + (size_t)L * 1024 * 1024;
    const float* g_mlp = (const float*)a->in[17] + L * 1024; const float* w_up = (const float*)a->in[18] + (size_t)L * 1024 * FF; const float* w_dn = (const float*)a->in[19] + (size_t)L * FF * 1024;
    const float* g_ple = (const float*)a->in[20] + L * 1024; const float* w_g = (const float*)a->in[21] + (size_t)L * 1024 * 1024; const float* w_ple = (const float*)a->in[22] + (size_t)L * PLE * 1024;
    for (int it = gw; it < NIT; it += NGW) {
        int r = it;
        if (r < I0) { wconv_item(w_in, 1024, INC, INP, wb + WO_IN, g_mix, g_mix, 1024, 0, scr, r, lane); continue; } r -= I0;
        if (r < I1) { wconv_item(w_uq, QL, 768, 768, wb + WO_UQ, g_ql, g_ql, QL, 1, scr, r, lane); continue; } r -= I1;
        if (r < I2) { wconv_item(w_ukv, KVL, 1024, 1024, wb + WO_UKV, g_kvl, g_kvl, KVL, 2, scr, r, lane); continue; } r -= I2;
        if (r < I3) { wconv_item(w_o, 1024, 1024, 1024, wb + WO_O, g_oa, g_oc, 512, 3, scr, r, lane); continue; } r -= I3;
        if (r < I4) { wconv_item(w_up, 1024, FF, FF, wb + WO_UP, g_mlp, g_mlp, 1024, 3, scr, r, lane); continue; } r -= I4;
        if (r < I5) { wconv_item(w_dn, FF, 1024, 1024, wb + WO_DN, nullptr, nullptr, 0, 3, scr, r, lane); continue; } r -= I5;
        if (r < I6) { wconv_item(w_g, 1024, 1024, 1024, wb + WO_G, g_ple, g_ple, 1024, 3, scr, r, lane); continue; } r -= I6;
        wconv_item(w_ple, PLE, 1024, 1024, wb + WO_PLE, nullptr, nullptr, 0, 3, scr, r, lane);
    }
}

#ifndef PH_MASK
#define PH_MASK 0xFFFF
#endif
#define PH(b) ((PH_MASK >> (b)) & 1)
__device__ __forceinline__ unsigned lds_word(unsigned byte_addr) { unsigned v; asm volatile("v_mov_b32 %0, %1\n\tds_read_b32 %0, %0\n\ts_waitcnt lgkmcnt(0)" : "=&v"(v) : "s"(byte_addr) : "memory"); return v; }
#define PHASE_ENV() \
    const __attribute__((address_space(4))) Args* ka_ = (const __attribute__((address_space(4))) Args*)__builtin_amdgcn_kernarg_segment_ptr(); asm volatile("" : "+s"(ka_)); \
    unsigned char* const ws = ka_->ws; float* const out = ka_->out; \
    int G = gridDim.x, bx = __builtin_amdgcn_readfirstlane((int)lds_word((unsigned)(__UINTPTR_TYPE__)lds + MISC_OFF + 64)); asm volatile("" : "+s"(G), "+s"(bx)); \
    const int vcu = (G % 8 == 0) ? (bx % 8) * (G / 8) + bx / 8 : bx; \
    int tidl_ = threadIdx.x; asm volatile("" : "+v"(tidl_)); const int tid = tidl_, lane = tid & 63, wave = __builtin_amdgcn_readfirstlane(tid >> 6); \
    const int gw = vcu * 8 + wave, NGW = G * 8; (void)gw; (void)NGW; (void)lane; (void)out; (void)tid; \
    bf16_t* const wb = (bf16_t*)(ws + WS_W0 + (size_t)(L % 3) * WS_WSTRIDE); (void)wb; \
    float* const XSA = (float*)(ws + (si ? WS_XS1 : WS_XS0)); float* const XSB = (float*)(ws + (si ? WS_XS0 : WS_XS1)); (void)XSA; (void)XSB;
#define KIN(i) ((const float*)ka_->in[i])

__global__ void __launch_bounds__(512, 2) trunk_fwd(Args args) {
    extern __shared__ __attribute__((aligned(16))) unsigned char lds_raw[];
    LAS unsigned char* lds = (LAS unsigned char*)lds_raw;
    volatile LAS unsigned* MISC = (volatile LAS unsigned*)(lds + MISC_OFF);
    for (int u = threadIdx.x; u < 32; u += 512) MISC[u] = (u == 16) ? blockIdx.x : 0u;
    __syncthreads();
    XcdBarrier bar = xcd_barrier_post((unsigned*)(args.ws + WS_CTL) + 1024, MISC + 8);
#define GRID_BAR() xcd_barrier(bar)

    {
        const int L = 0, si = 0;
        PHASE_ENV();
        if (PH(0)) { LAS float* scr = (LAS float*)(lds + wave * 16384); convert_weights(ka_, 0, (bf16_t*)(ws + WS_W0), scr, gw, NGW, lane); }
    }
    {
        const int L = 0, si = 0;
        PHASE_ENV();
        const float* x_in = KIN(0); bf16_t* XB = (bf16_t*)(ws + WS_XB);
        if (PH(1)) {
            f32x4 vn[4];
            if (gw < M) { const f32x4* xr = (const f32x4*)(x_in + (size_t)gw * 1024) + lane;
#pragma unroll
                for (int j = 0; j < 4; ++j) vn[j] = xr[64 * j]; }
            for (int m = gw; m < M; m += NGW) {
                f32x4 v[4]; float s = 0.f;
#pragma unroll
                for (int j = 0; j < 4; ++j) v[j] = vn[j];
                if (m + NGW < M) { const f32x4* xr = (const f32x4*)(x_in + (size_t)(m + NGW) * 1024) + lane;
#pragma unroll
                    for (int j = 0; j < 4; ++j) vn[j] = xr[64 * j]; }
#pragma unroll
                for (int j = 0; j < 4; ++j) s += dot4(v[j]);
                s = wave_sum(s);
                u32x2* o8 = (u32x2*)(XB + (size_t)m * 1024) + lane;
#pragma unroll
                for (int j = 0; j < 4; ++j) { u32x2 w; w.x = cvt_pk_bf16(v[j][0], v[j][1]); w.y = cvt_pk_bf16(v[j][2], v[j][3]); o8[64 * j] = w; }
                if (lane < 16) XSA[(size_t)m * 16 + lane] = (lane == 0) ? s : 0.f;
            }
        }
        const int* pos = (const int*)ka_->in[2]; float* COS = (float*)(ws + WS_COS); float* SIN = (float*)(ws + WS_SIN);
        if (PH(2)) for (int e = (bx * 512 + tid); e < M * 16; e += G * 512) {
            const int row = e >> 4, f = e & 15;
            const int fa = f & 3, fb = f >> 2;
            double inv = (fa == 0) ? 1.0 : (fa == 1) ? 0.5623413251903491 : (fa == 2) ? 0.31622776601683794 : 0.1778279410038923;
            inv *= (fb == 0) ? 1.0 : (fb == 1) ? 0.1 : (fb == 2) ? 0.01 : 0.001;
            const double ang = (double)pos[row] * inv;
            const double kk = __builtin_rint(ang * 0.15915494309189535);
            double r = __builtin_fma(-kk, 6.283185307179586, ang); r = __builtin_fma(-kk, 2.4492935982947064e-16, r);
            const double qd = __builtin_rint(r * 0.6366197723675814); const int qi = (int)qd;
            double y = __builtin_fma(-qd, 1.5707963267948966, r); y = __builtin_fma(-qd, 6.123233995736766e-17, y);
            const double y2 = y * y;
            double sp = -7.647163731819816e-13; sp = sp * y2 + 1.6059043836821613e-10; sp = sp * y2 - 2.505210838544172e-08; sp = sp * y2 + 2.7557319223985893e-06;
            sp = sp * y2 - 1.984126984126984e-04; sp = sp * y2 + 8.333333333333333e-03; sp = sp * y2 - 1.6666666666666666e-01; sp = y + y * y2 * sp;
            double cp = 4.779477332387385e-14; cp = cp * y2 - 1.1470745597729725e-11; cp = cp * y2 + 2.08767569878681e-09; cp = cp * y2 - 2.755731922398589e-07;
            cp = cp * y2 + 2.48015873015873e-05; cp = cp * y2 - 1.388888888888889e-03; cp = cp * y2 + 4.1666666666666664e-02; cp = cp * y2 - 0.5; cp = 1.0 + y2 * cp;
            const int qm = qi & 3;
            const double sv = (qm == 0) ? sp : (qm == 1) ? cp : (qm == 2) ? -sp : -cp;
            const double cv = (qm == 0) ? cp : (qm == 1) ? -sp : (qm == 2) ? -cp : sp;
            COS[e] = (float)cv; SIN[e] = (float)sv;
        }
    }
    if (args.ws == nullptr) cg::this_grid().sync();
    GRID_BAR();
    if (threadIdx.x == 0) {
        unsigned* bw = (unsigned*)(args.ws + WS_CTL) + 1024; const unsigned x = xb_xcc_id();
        unsigned pop = 0u, dense = 0u; bool ok = (gridDim.x == 256u);
#pragma unroll
        for (unsigned j = 0; j < 16; ++j) { const unsigned c = xb_ld(&bw[XB_XCNT(j)]); if (c) { ++pop; if (c != 32u) ok = false; if (j < x) ++dense; } }
        ok = ok && (pop == 8u);
        if (ok) { MISC[16] = MISC[18] * 8u + dense; MISC[17] = 1u; }
    }
    __syncthreads();
#define SEAM_LOCAL() do { if (__builtin_amdgcn_readfirstlane((int)lds_word((unsigned)(__UINTPTR_TYPE__)lds + MISC_OFF + 68))) xcd_local_barrier(bar, 32u); else xcd_barrier(bar); } while (0)

    int si = 0;
#pragma nounroll
    for (int L = 0; L < DEPTH; ++L) {
        if (PH(3)) {
            PHASE_ENV();
            pg8::Gemm g{(L == 0) ? (bf16_t*)(ws + WS_XB) : (bf16_t*)out, wb + WO_IN, M, INP, 1024, 1024}; pg8::StaticOrder S; S.init(M, INP, G, bx);
            pg8::EpiIn E{(bf16_t*)(ws + WS_Z), XSA, (float*)(ws + WS_ZS), (bf16_t*)(ws + WS_KPE), (const float*)(ws + WS_COS), (const float*)(ws + WS_SIN), KIN(12) + L * 32};
            pg8::gemm_phase(lds, g, S, E);
        }
        SEAM_LOCAL();
        if (PH(4)) {
            PHASE_ENV();
            pg8::Gemm g{(bf16_t*)(ws + WS_Z), wb + WO_UQ, M, 768, QL, INP}; pg8::StaticOrder S; S.init(M, 768, G, bx);
            pg8::EpiQ E{(bf16_t*)(ws + WS_Q), (const float*)(ws + WS_ZS), KIN(9) + L * 64, KIN(10) + L * 32, (const float*)(ws + WS_COS), (const float*)(ws + WS_SIN)};
            pg8::gemm_phase(lds, g, S, E);
        }
        if (PH(5)) {
            PHASE_ENV();
            pg8::Gemm g{(bf16_t*)(ws + WS_Z) + QL, wb + WO_UKV, M, 1024, KVL, INP}; pg8::StaticOrder S; S.init(M, 1024, G, bx);
            pg8::EpiKV E{(bf16_t*)(ws + WS_KN), (bf16_t*)(ws + WS_V), (const float*)(ws + WS_ZS), KIN(11) + L * 64};
            pg8::gemm_phase(lds, g, S, E);
        }
        SEAM_LOCAL();
        if (PH(6)) {
            PHASE_ENV();
            if (wave >= 4) __builtin_amdgcn_s_setprio(1);
            if (G == 256) {
                const int x = vcu >> 5, c = vcu & 31, i = c & 7;
                for (int r = 0; r < 2; ++r) {
                    const int bh = x * 8 + r * 4 + (c >> 3);
                    attn::attn_unit(bh >> 3, bh & 7, 15 - i, (const attn::bf16*)(ws + WS_Q), (const attn::bf16*)(ws + WS_KN), (const attn::bf16*)(ws + WS_KPE), (const attn::bf16*)(ws + WS_V), (attn::bf16*)(ws + WS_MIX), (float*)(ws + WS_ASS), (LAS char*)lds);
                    attn::attn_unit(bh >> 3, bh & 7, i, (const attn::bf16*)(ws + WS_Q), (const attn::bf16*)(ws + WS_KN), (const attn::bf16*)(ws + WS_KPE), (const attn::bf16*)(ws + WS_V), (attn::bf16*)(ws + WS_MIX), (float*)(ws + WS_ASS), (LAS char*)lds);
                }
            } else {
                for (int u = vcu; u < 64 * attn::NQB; u += G)
                    attn::attn_unit((u >> 4) >> 3, (u >> 4) & 7, u & 15, (const attn::bf16*)(ws + WS_Q), (const attn::bf16*)(ws + WS_KN), (const attn::bf16*)(ws + WS_KPE), (const attn::bf16*)(ws + WS_V), (attn::bf16*)(ws + WS_MIX), (float*)(ws + WS_ASS), (LAS char*)lds);
            }
            __builtin_amdgcn_s_setprio(0);
        }
        SEAM_LOCAL();
        if (PH(7)) {
            PHASE_ENV();
            const float* cw = KIN(13) + (size_t)L * 3 * 512;
            const float* pl = KIN(1) + (size_t)L * M * PLE;
            const bf16_t* Z = (const bf16_t*)(ws + WS_Z); bf16_t* MIX = (bf16_t*)(ws + WS_MIX); bf16_t* PB = (bf16_t*)(ws + WS_PB);
            for (int ch = gw; ch < M / 16; ch += NGW) {
                const int r0 = ch * 16, t0 = r0 & (SEQ - 1), c0 = lane * 8;
                float w0[8], w1[8], w2[8], u1[8], u2[8];
#pragma unroll
                for (int i = 0; i < 8; ++i) { w0[i] = cw[c0 + i]; w1[i] = cw[512 + c0 + i]; w2[i] = cw[1024 + c0 + i]; u1[i] = 0.f; u2[i] = 0.f; }
                if (t0 != 0) {
                    const u32x4 c1 = *(const u32x4*)(Z + (size_t)(r0 - 1) * INP + 1280 + c0), c2 = *(const u32x4*)(Z + (size_t)(r0 - 2) * INP + 1280 + c0);
#pragma unroll
                    for (int i = 0; i < 4; ++i) { u1[2 * i] = bf_lo(c1[i]); u1[2 * i + 1] = bf_hi(c1[i]); u2[2 * i] = bf_lo(c2[i]); u2[2 * i + 1] = bf_hi(c2[i]); }
                }
                u32x4 gb_n = *(const u32x4*)(Z + (size_t)r0 * INP + 768 + c0), gu_n = *(const u32x4*)(Z + (size_t)r0 * INP + 1280 + c0);
                f32x4 pv_n = *(const f32x4*)(pl + (size_t)r0 * PLE + lane * 4);
#pragma nounroll
                for (int rr = 0; rr < 16; ++rr) {
                    const int r = r0 + rr;
                    const u32x4 gb = gb_n, gu = gu_n; const f32x4 pv4 = pv_n;
                    if (rr < 15) { gb_n = *(const u32x4*)(Z + (size_t)(r + 1) * INP + 768 + c0); gu_n = *(const u32x4*)(Z + (size_t)(r + 1) * INP + 1280 + c0);
                                   pv_n = *(const f32x4*)(pl + (size_t)(r + 1) * PLE + lane * 4); }
                    float cv[8], uu[8]; float ss = 0.f;
#pragma unroll
                    for (int i = 0; i < 4; ++i) {
                        uu[2 * i] = bf_lo(gu[i]); uu[2 * i + 1] = bf_hi(gu[i]);
                        cv[2 * i] = bf_lo(gb[i]) * (w0[2 * i] * uu[2 * i] + w1[2 * i] * u1[2 * i] + w2[2 * i] * u2[2 * i]);
                        cv[2 * i + 1] = bf_hi(gb[i]) * (w0[2 * i + 1] * uu[2 * i + 1] + w1[2 * i + 1] * u1[2 * i + 1] + w2[2 * i + 1] * u2[2 * i + 1]);
                    }
#pragma unroll
                    for (int i = 0; i < 8; ++i) { ss += cv[i] * cv[i]; u2[i] = u1[i]; u1[i] = uu[i]; }
                    ss = wave_sum(ss);
                    const float rc = rsqrtf(ss * (1.0f / 512.0f) + EPS);
                    u32x4 oc;
#pragma unroll
                    for (int i = 0; i < 4; ++i) oc[i] = cvt_pk_bf16(cv[2 * i] * rc, cv[2 * i + 1] * rc);
                    *(u32x4*)(MIX + (size_t)r * 1024 + 512 + c0) = oc;
                    u32x2 pw; pw.x = cvt_pk_bf16(pv4[0], pv4[1]); pw.y = cvt_pk_bf16(pv4[2], pv4[3]);
                    *(u32x2*)(PB + (size_t)r * PLE + lane * 4) = pw;
                }
            }
            if (L + 1 < DEPTH) { LAS float* scr = (LAS float*)(lds + wave * 16384); convert_weights(ka_, L + 1, (bf16_t*)(ws + WS_W0 + (size_t)((L + 1) % 3) * WS_WSTRIDE), scr, gw, NGW, lane); }
        }
        GRID_BAR();
        if (PH(8)) {
            PHASE_ENV();
            pg8::Gemm g{(bf16_t*)(ws + WS_MIX), wb + WO_O, M, 1024, 1024, 1024}; pg8::StaticOrder S; S.init(M, 1024, G, bx);
            pg8::EpiRes<0, false> E{(L == 0) ? (const bf16_t*)(ws + WS_XB) : (const bf16_t*)out, (bf16_t*)(ws + WS_XB), nullptr, XSB, nullptr, nullptr, (const float*)(ws + WS_ASS)};
            pg8::gemm_phase<pg8::EpiRes<0, false>, true>(lds, g, S, E);
        }
        SEAM_LOCAL();
        if (PH(9)) {
            PHASE_ENV();
            pg8::Gemm g{(bf16_t*)(ws + WS_XB), wb + WO_UP, M, FF, 1024, 1024}; pg8::StaticOrder S; S.init(M, FF, G, bx);
            pg8::EpiUp E{(bf16_t*)(ws + WS_H)};
            pg8::gemm_phase(lds, g, S, E);
        }
        SEAM_LOCAL();
        if (PH(10)) {
            PHASE_ENV();
            pg8::Gemm g{(bf16_t*)(ws + WS_H), wb + WO_DN, M, 1024, FF, FF}; pg8::StaticOrder S; S.init(M, 1024, G, bx);
            pg8::EpiRes<2, false> E{(const bf16_t*)(ws + WS_XB), (bf16_t*)(ws + WS_XB), nullptr, XSA, XSB, nullptr};
            pg8::gemm_phase(lds, g, S, E);
        }
        if (L + 1 < DEPTH) SEAM_LOCAL(); else GRID_BAR();
        if (PH(11)) {
            { PHASE_ENV();
              pg8::Gemm g2{(bf16_t*)(ws + WS_PB), wb + WO_PLE, M, 1024, PLE, PLE}; pg8::StaticOrder S; S.init(M, 1024, G, bx);
              pg8::EpiPg E2{(bf16_t*)(ws + WS_MIX)};
              pg8::gemm_phase(lds, g2, S, E2); }
            { PHASE_ENV();
              pg8::Gemm g1{(bf16_t*)(ws + WS_XB), wb + WO_G, M, 1024, 1024, 1024}; pg8::StaticOrder S; S.init(M, 1024, G, bx);
              if (L + 1 < DEPTH) { pg8::EpiRes<1, false> E1{(const bf16_t*)(ws + WS_XB), (bf16_t*)out, nullptr, XSB, XSA, (const bf16_t*)(ws + WS_MIX)}; pg8::gemm_phase(lds, g1, S, E1); }
              else { pg8::EpiRes<1, true> E1{(const bf16_t*)(ws + WS_XB), nullptr, out, nullptr, XSA, (const bf16_t*)(ws + WS_MIX)}; pg8::gemm_phase(lds, g1, S, E1); } }
        }
        if (L + 1 < DEPTH) GRID_BAR();
        si ^= 1;
    }
}

extern "C" void kernel_launch(void* const* d_in, const int* in_sizes, int n_in, void* d_out, int out_size, void* d_ws, size_t ws_size, hipStream_t stream) {
    static int grid = 0;
    if (grid == 0) {
        if (n_in != 23 || in_sizes[0] != M * DMODEL || out_size != M * DMODEL || ws_size < WS_END) {
            fprintf(stderr, "kernel_launch: unexpected shapes (n_in %d, in0 %d, out %d, ws %zu); nothing launched\n", n_in, n_in > 0 ? in_sizes[0] : -1, out_size, ws_size); grid = -1; return; }
        int dev = 0, cus = 0, per_cu = 0;
        if (hipGetDevice(&dev) != hipSuccess || hipDeviceGetAttribute(&cus, hipDeviceAttributeMultiprocessorCount, dev) != hipSuccess) { grid = -1; return; }
        if (hipFuncSetAttribute((const void*)trunk_fwd, hipFuncAttributeMaxDynamicSharedMemorySize, LDS_BYTES) != hipSuccess) { fprintf(stderr, "kernel_launch: hipFuncSetAttribute failed\n"); grid = -1; return; }
        if (hipOccupancyMaxActiveBlocksPerMultiprocessor(&per_cu, (const void*)trunk_fwd, 512, LDS_BYTES) != hipSuccess || per_cu < 1) { fprintf(stderr, "kernel_launch: occupancy query says %d\n", per_cu); per_cu = 1; }
        (void)hipGetLastError();
        grid = cus * 1;
    }
    if (grid < 0) return;
    (void)hipMemsetAsync((char*)d_ws + WS_CTL, 0, CTL_ZERO_BYTES, stream);
    Args a{};
    for (int i = 0; i < 23; ++i) a.in[i] = d_in[i];
    a.out = (float*)d_out; a.ws = (unsigned char*)d_ws;
    void* kargs[] = {&a};
    hipError_t e = hipLaunchCooperativeKernel((const void*)trunk_fwd, dim3(grid), dim3(512), kargs, LDS_BYTES, stream);
    if (e != hipSuccess) fprintf(stderr, "kernel_launch: cooperative launch failed: %s (grid %d)\n", hipGetErrorString(e), grid);
}
```

```cpp
#include <hip/hip_runtime.h>
#include <hip/hip_cooperative_groups.h>
#include <hip/hip_bf16.h>
#include <cstdio>
#include <cstdint>
namespace cg = cooperative_groups;

#define LAS __attribute__((address_space(3)))
typedef unsigned short bf16_t;
typedef short bf16x8 __attribute__((ext_vector_type(8)));
typedef float f32x4 __attribute__((ext_vector_type(4)));
typedef float f32x2 __attribute__((ext_vector_type(2)));
typedef unsigned u32x4 __attribute__((ext_vector_type(4)));
typedef unsigned u32x2 __attribute__((ext_vector_type(2)));

constexpr int DMODEL = 1024, BATCH = 8, SEQ = 4096, DEPTH = 4, M = BATCH * SEQ;
constexpr int NH = 8, QL = 384, KVL = 256;
constexpr int INC = 2208, INP = 2304, FF = 4096, PLE = 256;
constexpr float EPS = 1e-6f;
constexpr float QSCALE = 0.10206207261596575f * 1.4426950408889634f;

constexpr size_t MiB = 1u << 20;
constexpr size_t WS_CTL = 0, CTL_ZERO_BYTES = 64 * 1024;
constexpr size_t WS_W0 = 1 * MiB, WS_WSTRIDE = 28 * MiB;
constexpr size_t WS_XB = 85 * MiB;
constexpr size_t WS_R = 149 * MiB;
constexpr size_t WS_Z = WS_R, WS_Q = WS_R + 144 * MiB, WS_KN = WS_R + 192 * MiB, WS_V = WS_R + 224 * MiB, WS_H = WS_R;
constexpr size_t WS_MIX = 405 * MiB;
constexpr size_t WS_PB = 469 * MiB;
constexpr size_t WS_KPE = 485 * MiB;
constexpr size_t WS_COS = 487 * MiB, WS_SIN = 489 * MiB;
constexpr size_t WS_XS0 = 491 * MiB, WS_XS1 = 493 * MiB;
constexpr size_t WS_ZS = 495 * MiB;
constexpr size_t WS_ASS = 499 * MiB;
constexpr size_t WS_END = 500 * MiB;
constexpr size_t WO_IN = 0, WO_UQ = WO_IN + (size_t)INP * 1024, WO_UKV = WO_UQ + 768 * 384, WO_O = WO_UKV + 1024 * 256, WO_UP = WO_O + 1024 * 1024,
                 WO_DN = WO_UP + (size_t)4096 * 1024, WO_G = WO_DN + (size_t)4096 * 1024, WO_PLE = WO_G + 1024 * 1024, WO_END = WO_PLE + 1024 * 256;
static_assert(WO_END * 2 <= 28 * MiB, "weight buffer");

constexpr int LDS_BYTES = 147456;
constexpr int MISC_OFF = 131072 + 320;

__device__ __forceinline__ unsigned cvt_pk_bf16(float lo, float hi) { unsigned r; asm volatile("v_cvt_pk_bf16_f32 %0, %1, %2" : "=v"(r) : "v"(lo), "v"(hi)); return r; }
__device__ __forceinline__ float bf_lo(unsigned w) { return __uint_as_float(w << 16); }
__device__ __forceinline__ float bf_hi(unsigned w) { return __uint_as_float(w & 0xffff0000u); }
__device__ __forceinline__ float wave_sum(float v) {
#pragma unroll
    for (int o = 1; o < 64; o <<= 1) v += __shfl_xor(v, o);
    return v;
}
__device__ __forceinline__ float dot4(f32x4 a) { return (a[0] * a[0] + a[1] * a[1]) + (a[2] * a[2] + a[3] * a[3]); }
__device__ __forceinline__ float fq_sum(float s) { s += __shfl_xor(s, 16); s += __shfl_xor(s, 32); return s; }

namespace pg8 {
constexpr int BM = 256, BK = 64, HALF = 128, HTB = HALF * BK * 2, STAGE_BYTES = 8 * HTB, NXCD = 8, WGM = 8;
__host__ __device__ __forceinline__ int lds_byte(int r, int c) { const int st = (r >> 4) * 2 + (c >> 5), rr = r & 15, cc = c & 31, ob = rr * 64 + cc * 2; return st * 1024 + (ob ^ (((ob >> 9) & 1) << 5)); }
__host__ __device__ __forceinline__ void stage_rc(int b, int& R, int& C) { const int st = b / 1024, sb = b % 1024, swz = sb ^ (((sb >> 9) & 1) << 5); R = (st >> 1) * 16 + swz / 64; C = (st & 1) * 32 + (swz % 64) / 2; }
__host__ __device__ __forceinline__ int perm32(int rho) { const int n = rho >> 4, i = rho & 15; return 8 * (i >> 2) + 4 * n + (i & 3); }

struct Unit { int pm, pn; };
struct Gemm { const bf16_t* A; const bf16_t* Bt; int M, N, K, lda; };

struct StaticOrder {
    int nM, nN, nwg, G, c;
    __device__ void init(int M_, int N_, int G_, int c_) { nM = M_ / BM; nN = N_ / BM; nwg = nM * nN; G = G_; c = c_; }
    __device__ bool next(int i, Unit& u) const {
        const long L = (long)i * G + c; if (L >= nwg) return false;
        int wgid = (int)L; { const int q = nwg / NXCD, r = nwg % NXCD, xcd = wgid % NXCD, off = wgid / NXCD; wgid = (xcd < r ? xcd * (q + 1) : r * (q + 1) + (xcd - r) * q) + off; }
        const int nig = WGM * nN, gid = wgid / nig, fm = gid * WGM, gsz = (nM - fm) < WGM ? (nM - fm) : WGM;
        u.pm = fm + ((wgid % nig) % gsz); u.pn = (wgid % nig) / gsz; return true;
    }
};

template <class Epi, bool MID = false>
__device__ __forceinline__ void gemm_phase(LAS unsigned char* lds, const Gemm g, const StaticOrder& S, const Epi& E) {
    int tid_ = threadIdx.x; asm volatile("" : "+v"(tid_));
    const int tid = tid_, wid = __builtin_amdgcn_readfirstlane(tid >> 6), lane = tid & 63, wr = wid >> 2, wc = wid & 3, fr = lane & 15, fq = lane >> 4;
    const int K = g.K, lda = g.lda; int nt = K / BK; asm volatile("" : "+s"(nt));
    unsigned voffA[2], voffB[2];
#pragma unroll
    for (int i = 0; i < 2; ++i) { int R, C; stage_rc(tid * 16 + i * 8192, R, C); const int Rb = (R & ~31) + perm32(R & 31);
        voffA[i] = (unsigned)(R * lda + C) * 2u; voffB[i] = (unsigned)(Rb * K + C) * 2u; }
    const size_t kstep = (size_t)(BK * 2);
    const size_t hstepA = (size_t)HALF * lda * 2, hstepB = (size_t)HALF * K * 2;
    const size_t tstepA = 2 * hstepA, tstepB = 2 * hstepB;
    const unsigned ldsw = (unsigned)wid * 1024u;
    const int aoff = lds_byte(wr * 64 + fr, fq * 8), boff = lds_byte(wc * 32 + fr, fq * 8);
#define PG8_SA(b, h) (((b) * 2 + (h)) * HTB)
#define PG8_SB(b, h) ((4 + (b) * 2 + (h)) * HTB)
#define PG8_STAGE(bufoff, gbase, voff) do { _Pragma("unroll") for (int _i = 0; _i < 2; ++_i) \
        __builtin_amdgcn_global_load_lds((const unsigned*)((const char*)(gbase) + (voff)[_i]), (LAS unsigned*)(lds + (bufoff) + ldsw + _i * 8192), 16, 0, 0); } while (0)
#define PG8_LDA(dst, b, h) do { _Pragma("unroll") for (int m = 0; m < 4; ++m) _Pragma("unroll") for (int k = 0; k < 2; ++k) dst[m][k] = *(const LAS bf16x8*)(lds + PG8_SA(b, h) + aoff + m * 2048 + k * 1024); } while (0)
#define PG8_LDB(dst, b, h) do { _Pragma("unroll") for (int n = 0; n < 2; ++n) _Pragma("unroll") for (int k = 0; k < 2; ++k) dst[n][k] = *(const LAS bf16x8*)(lds + PG8_SB(b, h) + boff + n * 2048 + k * 1024); } while (0)
#define PG8_MMA(ai, bj, At, Bt) do { __builtin_amdgcn_s_setprio(1); _Pragma("unroll") for (int m = 0; m < 4; ++m) _Pragma("unroll") for (int n = 0; n < 2; ++n) _Pragma("unroll") for (int k = 0; k < 2; ++k) \
        acc[ai][bj][m][n] = __builtin_amdgcn_mfma_f32_16x16x32_bf16(Bt[n][k], At[m][k], acc[ai][bj][m][n], 0, 0, 0); __builtin_amdgcn_s_setprio(0); } while (0)
#define PG8_WAIT_V(n) asm volatile("s_waitcnt vmcnt(" #n ")" ::: "memory")
#define PG8_WAIT_L(n) asm volatile("s_waitcnt lgkmcnt(" #n ")" ::: "memory")
#define PG8_BAR __builtin_amdgcn_s_barrier()
#define PG8_SCHED __builtin_amdgcn_sched_barrier(0)
    Unit cur, nxt; int ui = 0;
    if (!S.next(0, cur)) return;
    f32x4 acc[2][2][4][2];
#pragma unroll
    for (int a = 0; a < 2; ++a)
#pragma unroll
        for (int b = 0; b < 2; ++b)
#pragma unroll
            for (int m = 0; m < 4; ++m)
#pragma unroll
                for (int n = 0; n < 2; ++n) acc[a][b][m][n] = (f32x4){0.f, 0.f, 0.f, 0.f};
    bf16x8 At[4][2], B0[2][2], B1[2][2];
    const char* cA = (const char*)g.A + (size_t)cur.pm * tstepA; const char* cB = (const char*)g.Bt + (size_t)cur.pn * tstepB;
    PG8_STAGE(PG8_SB(0, 0), cB, voffB); PG8_STAGE(PG8_SB(0, 1), cB + hstepB, voffB); PG8_STAGE(PG8_SA(0, 0), cA, voffA); PG8_STAGE(PG8_SA(0, 1), cA + hstepA, voffA);
    if (wr == 1) PG8_BAR;
    PG8_WAIT_V(2); PG8_BAR;
    PG8_STAGE(PG8_SB(1, 0), cB + kstep, voffB); PG8_STAGE(PG8_SA(1, 0), cA + kstep, voffA); PG8_STAGE(PG8_SB(1, 1), cB + hstepB + kstep, voffB);
    PG8_WAIT_V(6); PG8_BAR;
    for (;;) {
        const bool has_next = S.next(ui + 1, nxt);
        const char* nA = has_next ? (const char*)g.A + (size_t)nxt.pm * tstepA : cA; const char* nB = has_next ? (const char*)g.Bt + (size_t)nxt.pn * tstepB : cB;
#pragma nounroll
        for (int t = 0; t < nt; t += 2) {
            const bool last = (t == nt - 2);
            const char* a1 = cA + (size_t)(t + 1) * kstep;
            const char* a2 = last ? nA : cA + (size_t)(t + 2) * kstep; const char* b2 = last ? nB : cB + (size_t)(t + 2) * kstep;
            const char* a3 = a2 + kstep; const char* b3 = b2 + kstep;
            PG8_LDB(B0, 0, 0); PG8_LDB(B1, 0, 1); PG8_SCHED; PG8_LDA(At, 0, 0); PG8_STAGE(PG8_SA(1, 1), a1 + hstepA, voffA);
            PG8_WAIT_V(8); PG8_WAIT_L(0); PG8_BAR; PG8_MMA(0, 0, At, B0); PG8_MMA(0, 1, At, B1); PG8_BAR; PG8_SCHED;
            PG8_LDA(At, 0, 1); PG8_STAGE(PG8_SB(0, 0), b2, voffB); PG8_STAGE(PG8_SB(0, 1), b2 + hstepB, voffB); PG8_STAGE(PG8_SA(0, 0), a2, voffA);
            PG8_WAIT_V(8); PG8_WAIT_L(0); PG8_BAR; PG8_MMA(1, 0, At, B0); PG8_MMA(1, 1, At, B1); PG8_BAR; PG8_SCHED;
            PG8_LDB(B0, 1, 0); PG8_LDB(B1, 1, 1); PG8_SCHED; PG8_LDA(At, 1, 0); PG8_STAGE(PG8_SA(0, 1), a2 + hstepA, voffA);
            PG8_WAIT_V(8); PG8_WAIT_L(0); PG8_BAR; PG8_MMA(0, 0, At, B0); PG8_MMA(0, 1, At, B1); PG8_BAR; PG8_SCHED;
            PG8_LDA(At, 1, 1); PG8_STAGE(PG8_SB(1, 0), b3, voffB); PG8_STAGE(PG8_SB(1, 1), b3 + hstepB, voffB); PG8_STAGE(PG8_SA(1, 0), a3, voffA);
            PG8_WAIT_V(8); PG8_WAIT_L(0); PG8_BAR; PG8_MMA(1, 0, At, B0); PG8_MMA(1, 1, At, B1); PG8_BAR; PG8_SCHED;
            if constexpr (MID) { if (t == 6) E.mid(acc, cur, wr, wc, fr, fq); }
        }
        if (wr == 0) PG8_BAR;
        E(acc, cur, wr, wc, fr, fq);
        if (!has_next) break;
#pragma unroll
        for (int a = 0; a < 2; ++a)
#pragma unroll
            for (int b = 0; b < 2; ++b)
#pragma unroll
                for (int m = 0; m < 4; ++m)
#pragma unroll
                    for (int n = 0; n < 2; ++n) acc[a][b][m][n] = (f32x4){0.f, 0.f, 0.f, 0.f};
        cur = nxt; cA = nA; cB = nB; ++ui;
        if (wr == 1) PG8_BAR;
    }
    PG8_WAIT_V(0);
    PG8_BAR;
#undef PG8_SA
#undef PG8_SB
#undef PG8_STAGE
#undef PG8_LDA
#undef PG8_LDB
#undef PG8_MMA
#undef PG8_WAIT_V
#undef PG8_WAIT_L
#undef PG8_BAR
#undef PG8_SCHED
}

__device__ __forceinline__ float rstd16(const float* xs, int row, int fq, float invn) {
    const f32x4 p = *(const f32x4*)(xs + (size_t)row * 16 + fq * 4);
    const float s = fq_sum((p[0] + p[1]) + (p[2] + p[3]));
    return rsqrtf(s * invn + EPS);
}
__device__ __forceinline__ void rstd8(float (&rs)[2][4], const float* xs, int rowb, int stride, int fq, int lim, float invn) {
    f32x4 p[2][4];
#pragma unroll
    for (int ai = 0; ai < 2; ++ai)
#pragma unroll
        for (int m = 0; m < 4; ++m) { p[ai][m] = (f32x4){0.f, 0.f, 0.f, 0.f}; if (fq < lim) p[ai][m] = *(const f32x4*)(xs + (size_t)(rowb + ai * 128 + m * 16) * stride + fq * 4); }
#pragma unroll
    for (int ai = 0; ai < 2; ++ai)
#pragma unroll
        for (int m = 0; m < 4; ++m) rs[ai][m] = rsqrtf(fq_sum((p[ai][m][0] + p[ai][m][1]) + (p[ai][m][2] + p[ai][m][3])) * invn + EPS);
}
__device__ __forceinline__ u32x4 pack8(f32x4 a, f32x4 b) { u32x4 w; w.x = cvt_pk_bf16(a[0], a[1]); w.y = cvt_pk_bf16(a[2], a[3]); w.z = cvt_pk_bf16(b[0], b[1]); w.w = cvt_pk_bf16(b[2], b[3]); return w; }

struct EpiIn {
    bf16_t* z; const float* xs; float* zs; bf16_t* kpe; const float* cs; const float* sn; const float* gk;
    __device__ __forceinline__ void operator()(const f32x4 (&acc)[2][2][4][2], const Unit& u, int wr, int wc, int fr, int fq) const {
        const int colb = u.pn * 256 + wc * 32 + 8 * fq;
        float rs8[2][4]; rstd8(rs8, xs, u.pm * 256 + wr * 64 + fr, 16, fq, 4, 1.0f / 1024.0f);
#pragma unroll
        for (int ai = 0; ai < 2; ++ai)
#pragma unroll
            for (int m = 0; m < 4; ++m) {
                const int row = u.pm * 256 + ai * 128 + wr * 64 + m * 16 + fr;
                const float rs = rs8[ai][m];
                if (u.pn >= 5) {
                    const f32x4 u0 = (acc[ai][0][m][0] * rs) * (acc[ai][1][m][0] * rs), u1 = (acc[ai][0][m][1] * rs) * (acc[ai][1][m][1] * rs);
                    *(u32x4*)(z + (size_t)row * INP + 1280 + (u.pn - 5) * 128 + wc * 32 + 8 * fq) = pack8(u0, u1);
                } else
#pragma unroll
                for (int bj = 0; bj < 2; ++bj) {
                    const f32x4 v0 = acc[ai][bj][m][0] * rs, v1 = acc[ai][bj][m][1] * rs;
                    const int hb = 2 * u.pn + bj;
                    if (hb < 5) { const float s = fq_sum(dot4(v0) + dot4(v1)); if (fq == 0) zs[(size_t)row * 32 + (hb < 3 ? hb * 4 : 16 + (hb - 3) * 4) + wc] = s; }
                    if (hb == 5 && wc == 0) {
                        const float ss = fq_sum(dot4(v0) + dot4(v1)); const float rn = rsqrtf(ss * (1.0f / 32.0f) + EPS);
                        const f32x4 g1 = *(const f32x4*)(gk + 4 * fq), g2 = *(const f32x4*)(gk + 16 + 4 * fq);
                        const f32x4 c = *(const f32x4*)(cs + (size_t)row * 16 + 4 * fq), s = *(const f32x4*)(sn + (size_t)row * 16 + 4 * fq);
                        const f32x4 a = v0 * rn * g1, b = v1 * rn * g2;
                        *(u32x4*)(kpe + (size_t)row * 32 + 8 * fq) = pack8(a * c - b * s, b * c + a * s);
                    }
                    *(u32x4*)(z + (size_t)row * INP + colb + bj * 128) = pack8(v0, v1);
                }
            }
    }
};
struct EpiQ {
    bf16_t* Q; const float* zs; const float* gn; const float* gr; const float* cs; const float* sn;
    __device__ __forceinline__ void operator()(const f32x4 (&acc)[2][2][4][2], const Unit& u, int wr, int wc, int fr, int fq) const {
        float rs8[2][4]; rstd8(rs8, zs, u.pm * 256 + wr * 64 + fr, 32, fq, 3, 1.0f / 384.0f);
#pragma unroll
        for (int ai = 0; ai < 2; ++ai)
#pragma unroll
            for (int m = 0; m < 4; ++m) {
                const int row = u.pm * 256 + ai * 128 + wr * 64 + m * 16 + fr;
                const float rs = rs8[ai][m];
                if (u.pn < 2) {
                    const int h = 4 * u.pn + wc;
                    f32x4 v[2][2]; float ss = 0.f;
#pragma unroll
                    for (int bj = 0; bj < 2; ++bj)
#pragma unroll
                        for (int n = 0; n < 2; ++n) { v[bj][n] = acc[ai][bj][m][n] * rs; ss += dot4(v[bj][n]); }
                    const float rn = rsqrtf(fq_sum(ss) * (1.0f / 64.0f) + EPS) * QSCALE;
#pragma unroll
                    for (int bj = 0; bj < 2; ++bj) {
                        const f32x4 g0 = *(const f32x4*)(gn + 32 * bj + 8 * fq), g1 = *(const f32x4*)(gn + 32 * bj + 8 * fq + 4);
                        *(u32x4*)(Q + (size_t)row * 768 + h * 96 + 32 * bj + 8 * fq) = pack8(v[bj][0] * rn * g0, v[bj][1] * rn * g1);
                    }
                } else {
                    const f32x4 c = *(const f32x4*)(cs + (size_t)row * 16 + 4 * fq), s = *(const f32x4*)(sn + (size_t)row * 16 + 4 * fq);
                    const f32x4 g1 = *(const f32x4*)(gr + 4 * fq), g2 = *(const f32x4*)(gr + 16 + 4 * fq);
#pragma unroll
                    for (int bj = 0; bj < 2; ++bj) {
                        const int h = 4 * bj + wc;
                        const f32x4 v0 = acc[ai][bj][m][0] * rs, v1 = acc[ai][bj][m][1] * rs;
                        const float rn = rsqrtf(fq_sum(dot4(v0) + dot4(v1)) * (1.0f / 32.0f) + EPS);
                        const f32x4 a = v0 * rn * g1, b = v1 * rn * g2;
                        *(u32x4*)(Q + (size_t)row * 768 + h * 96 + 64 + 8 * fq) = pack8((a * c - b * s) * QSCALE, (b * c + a * s) * QSCALE);
                    }
                }
            }
    }
};
struct EpiKV {
    bf16_t* Kn; bf16_t* V; const float* zs; const float* gn;
    __device__ __forceinline__ void operator()(const f32x4 (&acc)[2][2][4][2], const Unit& u, int wr, int wc, int fr, int fq) const {
        float rs8[2][4]; rstd8(rs8, zs + 16, u.pm * 256 + wr * 64 + fr, 32, fq, 2, 1.0f / 256.0f);
#pragma unroll
        for (int ai = 0; ai < 2; ++ai)
#pragma unroll
            for (int m = 0; m < 4; ++m) {
                const int row = u.pm * 256 + ai * 128 + wr * 64 + m * 16 + fr;
                const float rs = rs8[ai][m];
                if (u.pn < 2) {
                    const int h = 4 * u.pn + wc;
                    f32x4 v[2][2]; float ss = 0.f;
#pragma unroll
                    for (int bj = 0; bj < 2; ++bj)
#pragma unroll
                        for (int n = 0; n < 2; ++n) { v[bj][n] = acc[ai][bj][m][n] * rs; ss += dot4(v[bj][n]); }
                    const float rn = rsqrtf(fq_sum(ss) * (1.0f / 64.0f) + EPS);
#pragma unroll
                    for (int bj = 0; bj < 2; ++bj) {
                        const f32x4 g0 = *(const f32x4*)(gn + 32 * bj + 8 * fq), g1 = *(const f32x4*)(gn + 32 * bj + 8 * fq + 4);
                        *(u32x4*)(Kn + (size_t)row * 512 + h * 64 + 32 * bj + 8 * fq) = pack8(v[bj][0] * rn * g0, v[bj][1] * rn * g1);
                    }
                } else {
#pragma unroll
                    for (int bj = 0; bj < 2; ++bj)
                        *(u32x4*)(V + (size_t)row * 512 + (u.pn - 2) * 256 + bj * 128 + wc * 32 + 8 * fq) = pack8(acc[ai][bj][m][0] * rs, acc[ai][bj][m][1] * rs);
                }
            }
    }
};
struct EpiUp {
    bf16_t* H;
    __device__ __forceinline__ void operator()(const f32x4 (&acc)[2][2][4][2], const Unit& u, int wr, int wc, int fr, int fq) const {
        const int colb = u.pn * 256 + wc * 32 + 8 * fq;
#pragma unroll
        for (int ai = 0; ai < 2; ++ai)
#pragma unroll
            for (int m = 0; m < 4; ++m) {
                const int row = u.pm * 256 + ai * 128 + wr * 64 + m * 16 + fr;
#pragma unroll
                for (int bj = 0; bj < 2; ++bj) {
                    f32x4 v0 = acc[ai][bj][m][0], v1 = acc[ai][bj][m][1];
#pragma unroll
                    for (int i = 0; i < 4; ++i) { const float a = fmaxf(v0[i], 0.f), b = fmaxf(v1[i], 0.f); v0[i] = a * a; v1[i] = b * b; }
                    *(u32x4*)(H + (size_t)row * FF + colb + bj * 128) = pack8(v0, v1);
                }
            }
    }
};
struct EpiPg {
    bf16_t* pg;
    __device__ __forceinline__ void operator()(const f32x4 (&acc)[2][2][4][2], const Unit& u, int wr, int wc, int fr, int fq) const {
        const int colb = u.pn * 256 + wc * 32 + 8 * fq;
#pragma unroll
        for (int ai = 0; ai < 2; ++ai)
#pragma unroll
            for (int m = 0; m < 4; ++m) {
                const int row = u.pm * 256 + ai * 128 + wr * 64 + m * 16 + fr;
#pragma unroll
                for (int bj = 0; bj < 2; ++bj) *(u32x4*)(pg + (size_t)row * 1024 + colb + bj * 128) = pack8(acc[ai][bj][m][0], acc[ai][bj][m][1]);
            }
    }
};
template <int MODE, bool LAST> struct EpiRes {
    const bf16_t* xold; bf16_t* xb; float* xout; float* xs_out; const float* xs_in; const bf16_t* pg; const float* ass;
    __device__ __forceinline__ void mid(f32x4 (&acc)[2][2][4][2], const Unit& u, int wr, int wc, int fr, int fq) const {
        f32x4 p[2][4];
        int rowb = u.pm * 256 + wr * 64 + fr; asm volatile("" : "+v"(rowb));
#pragma unroll
        for (int ai = 0; ai < 2; ++ai)
#pragma unroll
            for (int m = 0; m < 4; ++m) p[ai][m] = *(const f32x4*)(ass + (size_t)(rowb + ai * 128 + m * 16) * 8 + (fq & 1) * 4);
#pragma unroll
        for (int ai = 0; ai < 2; ++ai)
#pragma unroll
            for (int m = 0; m < 4; ++m) {
                float sq = (p[ai][m][0] + p[ai][m][1]) + (p[ai][m][2] + p[ai][m][3]); sq += __shfl_xor(sq, 16);
                const float rs = rsqrtf(sq * (1.0f / 512.0f) + EPS);
#pragma unroll
                for (int bj = 0; bj < 2; ++bj)
#pragma unroll
                    for (int n = 0; n < 2; ++n) acc[ai][bj][m][n] = acc[ai][bj][m][n] * rs;
            }
    }
    __device__ __forceinline__ void operator()(const f32x4 (&acc)[2][2][4][2], const Unit& u, int wr, int wc, int fr, int fq) const {
        const int colb = u.pn * 256 + wc * 32 + 8 * fq;
        float rs8[2][4];
        if (MODE != 0) rstd8(rs8, xs_in, u.pm * 256 + wr * 64 + fr, 16, fq, 4, 1.0f / 1024.0f);
        constexpr int NB = (MODE == 1) ? 2 : 4;
#pragma unroll
        for (int g = 0; g < 8 / NB; ++g) {
            u32x4 xw[NB][2], pw[NB][2];
#pragma unroll
            for (int k = 0; k < NB; ++k)
#pragma unroll
                for (int bj = 0; bj < 2; ++bj) {
                    const int ai = (g * NB + k) >> 2, m = (g * NB + k) & 3;
                    const size_t off = (size_t)(u.pm * 256 + ai * 128 + wr * 64 + m * 16 + fr) * 1024 + colb + bj * 128;
                    xw[k][bj] = *(const u32x4*)(xold + off);
                    if (MODE == 1) pw[k][bj] = *(const u32x4*)(pg + off);
                }
#pragma unroll
            for (int k = 0; k < NB; ++k) {
                const int ai = (g * NB + k) >> 2, m = (g * NB + k) & 3;
                const int row = u.pm * 256 + ai * 128 + wr * 64 + m * 16 + fr;
                float ss = 0.f;
#pragma unroll
                for (int bj = 0; bj < 2; ++bj) {
                    const size_t off = (size_t)row * 1024 + colb + bj * 128;
                    const u32x4 w = xw[k][bj];
                    const f32x4 x0 = (f32x4){bf_lo(w.x), bf_hi(w.x), bf_lo(w.y), bf_hi(w.y)}, x1 = (f32x4){bf_lo(w.z), bf_hi(w.z), bf_lo(w.w), bf_hi(w.w)};
                    f32x4 d0 = acc[ai][bj][m][0], d1 = acc[ai][bj][m][1];
                    if (MODE == 2) { const float r2 = rs8[ai][m] * rs8[ai][m]; d0 = d0 * r2; d1 = d1 * r2; }
                    if (MODE == 1) {
                        const float rs = rs8[ai][m];
                        const u32x4 q = pw[k][bj];
                        const f32x4 p0 = (f32x4){bf_lo(q.x), bf_hi(q.x), bf_lo(q.y), bf_hi(q.y)}, p1 = (f32x4){bf_lo(q.z), bf_hi(q.z), bf_lo(q.w), bf_hi(q.w)};
#pragma unroll
                        for (int i = 0; i < 4; ++i) { d0[i] = p0[i] * __builtin_amdgcn_rcpf(1.0f + __expf(-d0[i] * rs)); d1[i] = p1[i] * __builtin_amdgcn_rcpf(1.0f + __expf(-d1[i] * rs)); }
                    }
                    const f32x4 y0 = x0 + d0, y1 = x1 + d1;
                    if (LAST) { *(f32x4*)(xout + off) = y0; *(f32x4*)(xout + off + 4) = y1; }
                    else { ss += dot4(y0) + dot4(y1); *(u32x4*)(xb + off) = pack8(y0, y1); }
                }
                if (!LAST) { ss = fq_sum(ss); if (fq == 0) xs_out[(size_t)row * 16 + u.pn * 4 + wc] = ss; }
            }
            asm volatile("" ::: "memory");
        }
    }
};
}

namespace attn {
using bf16 = __hip_bfloat16;
using s16x4 = __attribute__((ext_vector_type(4))) short;
using f32x16 = __attribute__((ext_vector_type(16))) float;
constexpr int NW = 8, QBLK = 32, QB = 256, KVBLK = 64, NQB = SEQ / QB;
constexpr int QP = 768, KNP = 512, KPP = 32, VP = 512, OP = 1024;
constexpr int KSLOT = 12288, VSLOT = 8192, NSLOT = 3;
constexpr int LDS_K = 0, LDS_V = NSLOT * KSLOT, LDS_WS = LDS_V + 4 * VSLOT, LDS_OST = LDS_WS + NW * 256, LDS_TOTAL = LDS_OST + NW * 4096;
static_assert(LDS_TOTAL <= 131072, "attention LDS");
__device__ __forceinline__ int crow(int r, int hi) { return (r & 3) + 8 * (r >> 2) + 4 * hi; }
#define SBAR() __builtin_amdgcn_sched_barrier(0)
__device__ __forceinline__ void cmask(f32x16& p0, f32x16& p1, int jb, int qrel, int hi) {
    const float NEG = -INFINITY; const int kb = 64 * jb + 4 * hi;
#pragma unroll
    for (int r = 0; r < 16; ++r) { const int kv = kb + (r & 3) + 8 * (r >> 2); if (kv > qrel) p0[r] = NEG; if (kv + 32 > qrel) p1[r] = NEG; }
}
__device__ __forceinline__ void glds16(const void* gsrc, unsigned lds_dst) { unsigned keep;
    asm volatile("s_mov_b32 %0, m0\n\ts_mov_b32 m0, %2\n\ts_nop 0\n\tglobal_load_lds_dwordx4 %1, off\n\ts_mov_b32 m0, %0" : "=&s"(keep) : "v"(gsrc), "s"(lds_dst) : "memory"); }
__device__ __forceinline__ float max3f(float a, float b, float c) { return __builtin_fmaxf(__builtin_fmaxf(a, b), c); }
__device__ __forceinline__ float rowmax(const f32x16& p0, const f32x16& p1) {
    float a = max3f(p0[0], p0[1], p1[0]), b = max3f(p0[2], p0[3], p1[1]); a = max3f(a, p1[2], p1[3]);
#pragma unroll
    for (int r = 4; r < 16; r += 4) { a = max3f(a, p0[r], p0[r + 1]); b = max3f(b, p0[r + 2], p0[r + 3]); a = max3f(a, p1[r], p1[r + 1]); b = max3f(b, p1[r + 2], p1[r + 3]); }
    const float m = __builtin_fmaxf(a, b);
    auto rr = __builtin_amdgcn_permlane32_swap(__float_as_uint(m), __float_as_uint(m), false, false);
    return __builtin_fmaxf(__uint_as_float(rr[0]), __uint_as_float(rr[1]));
}
#define WAIT_BAR(N) asm volatile("s_waitcnt vmcnt(" #N ") lgkmcnt(0)\n\ts_barrier" ::: "memory")
__device__ __forceinline__ void qkt(f32x16& p0, f32x16& p1, const LAS char* Kslot, const bf16x8* qr, int r32, int hi) {
    const LAS char* kb = Kslot + hi * 1024 + r32 * 16;
    const f32x16 zero = f32x16{};
#pragma unroll
    for (int d0 = 0; d0 < 6; ++d0) {
        const bf16x8 b0 = *(const LAS bf16x8*)(kb + d0 * 2048);
        const bf16x8 b1 = *(const LAS bf16x8*)(kb + d0 * 2048 + 512);
        if (d0 == 0) { p0 = __builtin_amdgcn_mfma_f32_32x32x16_bf16(b0, qr[0], zero, 0, 0, 0); p1 = __builtin_amdgcn_mfma_f32_32x32x16_bf16(b1, qr[0], zero, 0, 0, 0); }
        else { p0 = __builtin_amdgcn_mfma_f32_32x32x16_bf16(b0, qr[d0], p0, 0, 0, 0); p1 = __builtin_amdgcn_mfma_f32_32x32x16_bf16(b1, qr[d0], p1, 0, 0, 0); }
    }
}
__device__ __forceinline__ void pv(f32x16* o, int vb, bf16x8 pa0, bf16x8 pa1, bf16x8 pa2, bf16x8 pa3) {
#pragma unroll
    for (int d0 = 0; d0 < 2; ++d0) { s16x4 lo[4], hi[4];
#pragma unroll
        for (int ks = 0; ks < 4; ++ks) {
            asm volatile("ds_read_b64_tr_b16 %0,%1 offset:%c2" : "=&v"(lo[ks]) : "v"(vb), "i"(d0 * 4096 + ks * 1024) : "memory");
            asm volatile("ds_read_b64_tr_b16 %0,%1 offset:%c2" : "=&v"(hi[ks]) : "v"(vb), "i"(d0 * 4096 + ks * 1024 + 512) : "memory"); }
        asm volatile("s_waitcnt lgkmcnt(0)" ::: "memory"); SBAR();
#define PK(k) (bf16x8){lo[k][0], lo[k][1], lo[k][2], lo[k][3], hi[k][0], hi[k][1], hi[k][2], hi[k][3]}
        o[d0] = __builtin_amdgcn_mfma_f32_32x32x16_bf16(pa0, PK(0), o[d0], 0, 0, 0);
        o[d0] = __builtin_amdgcn_mfma_f32_32x32x16_bf16(pa1, PK(1), o[d0], 0, 0, 0);
        o[d0] = __builtin_amdgcn_mfma_f32_32x32x16_bf16(pa2, PK(2), o[d0], 0, 0, 0);
        o[d0] = __builtin_amdgcn_mfma_f32_32x32x16_bf16(pa3, PK(3), o[d0], 0, 0, 0);
#undef PK
    }
}
typedef short v4i16_t __attribute__((ext_vector_type(4)));
__device__ __forceinline__ s16x4 vtr(const LAS char* p) { return __builtin_bit_cast(s16x4, __builtin_amdgcn_ds_read_tr16_b64_v4i16((LAS v4i16_t*)p)); }
__device__ __forceinline__ unsigned cvtpk_s(float lo, float hi) { f32x2 v = {lo, hi}; typedef __bf16 bf16x2_t __attribute__((ext_vector_type(2))); bf16x2_t b = __builtin_convertvector(v, bf16x2_t); return __builtin_bit_cast(unsigned, b); }

__device__ __forceinline__ void attn_unit(int b, int h, int qb, const bf16* Q, const bf16* __restrict__ Kn, const bf16* __restrict__ Kpe, const bf16* __restrict__ V, bf16* O, float* ASS, LAS char* shm) {
    int tid_ = threadIdx.x; asm volatile("" : "+v"(tid_));
    const int tid = tid_, lane = tid & 63, r32 = lane & 31, hi = lane >> 5; const int wid = __builtin_amdgcn_readfirstlane(tid >> 6);
    const long rowbase = (long)b * SEQ; const int q0 = qb * QB;
    const bf16* Qw = Q + (rowbase + q0 + wid * QBLK) * QP + h * 96;
    const unsigned lds0 = (unsigned)(uintptr_t)shm;
    LAS float* wsf = (LAS float*)(shm + LDS_WS) + wid * 64;
    const bf16* ksrc = Kn + (rowbase + lane) * KNP + h * 64 + wid * 8;
    const bf16* k2src = Kpe + (rowbase + lane) * KPP + (wid & 3) * 8;
    const bf16* vsrc = V + (rowbase + 16 * (wid & 3) + (lane >> 2)) * VP + h * 64 + (wid >> 2) * 32 + (lane & 3) * 8;
    const unsigned kdst = lds0 + LDS_K + wid * 1024, k2dst = lds0 + LDS_K + (8 + (wid & 3)) * 1024, vdst = lds0 + LDS_V + wid * 1024;
#define DMA_TILE(t, ks, vs) do { glds16(ksrc + (long)(t) * KVBLK * KNP, (unsigned)__builtin_amdgcn_readfirstlane(kdst + (ks) * KSLOT)); \
        glds16(k2src + (long)(t) * KVBLK * KPP, (unsigned)__builtin_amdgcn_readfirstlane(k2dst + (ks) * KSLOT)); \
        glds16(vsrc + (long)(t) * KVBLK * VP, (unsigned)__builtin_amdgcn_readfirstlane(vdst + (vs) * VSLOT)); } while (0)
    const int vb0 = (int)(lds0 + LDS_V) + ((lane >> 4) & 1) * 32 + (lane & 3) * 8 + (4 * hi + ((lane & 15) >> 2)) * 64;
    const int NT = (q0 + QB) / KVBLK;
    DMA_TILE(0, 0, 0); DMA_TILE(1, 1, 1);
    bf16x8 qr[6];
#pragma unroll
    for (int d0 = 0; d0 < 6; ++d0) qr[d0] = *reinterpret_cast<const bf16x8*>(&Qw[(long)r32 * QP + d0 * 16 + hi * 8]);
    asm volatile("" : "+v"(qr[0]), "+v"(qr[1]), "+v"(qr[2]), "+v"(qr[3]), "+v"(qr[4]), "+v"(qr[5]));
    float m_run = -1e30f, l_run = 0.f; f32x16 o[2]; o[0] = f32x16{}; o[1] = f32x16{};
    const int qrel = wid * QBLK + r32;
    f32x16 p0, p1;
    bf16x8 kf[12]; s16x4 vlo[8], vhi[8]; u32x4 pw0, pw1, pw2, pw3;
    const LAS char* kp0 = shm + LDS_K + hi * 1024 + r32 * 16;
    const LAS char* vp0 = shm + LDS_V + ((lane >> 4) & 1) * 32 + (lane & 3) * 8 + (4 * hi + ((lane & 15) >> 2)) * 64;
#define K_LOAD(ks) do { const LAS char* kp_ = kp0 + (ks) * KSLOT; \
        _Pragma("unroll") for (int i_ = 0; i_ < 6; ++i_) { kf[2 * i_] = *(const LAS bf16x8*)(kp_ + i_ * 2048); kf[2 * i_ + 1] = *(const LAS bf16x8*)(kp_ + i_ * 2048 + 512); } SBAR(); } while (0)
#define V_LOAD(vs) do { const LAS char* vp_ = vp0 + (vs) * VSLOT; \
        _Pragma("unroll") for (int i_ = 0; i_ < 8; ++i_) { vlo[i_] = vtr(vp_ + ((i_ >> 2) * 4096 + (i_ & 3) * 1024)); vhi[i_] = vtr(vp_ + ((i_ >> 2) * 4096 + (i_ & 3) * 1024 + 512)); } SBAR(); } while (0)
#define QK_MMA(t) do { const f32x16 zero_ = f32x16{}; \
        p0 = __builtin_amdgcn_mfma_f32_32x32x16_bf16(kf[0], qr[0], zero_, 0, 0, 0); p1 = __builtin_amdgcn_mfma_f32_32x32x16_bf16(kf[1], qr[0], zero_, 0, 0, 0); \
        _Pragma("unroll") for (int i_ = 1; i_ < 6; ++i_) { p0 = __builtin_amdgcn_mfma_f32_32x32x16_bf16(kf[2 * i_], qr[i_], p0, 0, 0, 0); p1 = __builtin_amdgcn_mfma_f32_32x32x16_bf16(kf[2 * i_ + 1], qr[i_], p1, 0, 0, 0); } \
        if ((t) >= NT - 4) cmask(p0, p1, (t) - (NT - 4), qrel, hi); SBAR(); } while (0)
#define SOFTMAX() do { \
        const float rm = rowmax(p0, p1); \
        if (__builtin_expect(__any(rm > m_run + 8.0f), 0)) { \
            const float mn = __builtin_fmaxf(m_run, rm); const float alpha = __builtin_amdgcn_exp2f(m_run - mn); \
            l_run *= alpha; m_run = mn; if (hi == 0) wsf[r32] = alpha; \
            asm volatile("s_waitcnt lgkmcnt(0)" ::: "memory"); \
            _Pragma("unroll") for (int r = 0; r < 16; ++r) { const float f = wsf[crow(r, hi)]; o[0][r] *= f; o[1][r] *= f; } \
        } \
        float sacc = 0.f; \
        _Pragma("unroll") for (int r = 0; r < 16; ++r) { p0[r] = __builtin_amdgcn_exp2f(p0[r] - m_run); p1[r] = __builtin_amdgcn_exp2f(p1[r] - m_run); sacc += p0[r] + p1[r]; } \
        l_run += sacc; \
        pw0 = (u32x4){cvtpk_s(p0[0], p0[1]), cvtpk_s(p0[2], p0[3]), cvtpk_s(p0[4], p0[5]), cvtpk_s(p0[6], p0[7])}; \
        pw1 = (u32x4){cvtpk_s(p0[8], p0[9]), cvtpk_s(p0[10], p0[11]), cvtpk_s(p0[12], p0[13]), cvtpk_s(p0[14], p0[15])}; \
        pw2 = (u32x4){cvtpk_s(p1[0], p1[1]), cvtpk_s(p1[2], p1[3]), cvtpk_s(p1[4], p1[5]), cvtpk_s(p1[6], p1[7])}; \
        pw3 = (u32x4){cvtpk_s(p1[8], p1[9]), cvtpk_s(p1[10], p1[11]), cvtpk_s(p1[12], p1[13]), cvtpk_s(p1[14], p1[15])}; \
        SBAR(); } while (0)
#define VFR(i) (bf16x8){vlo[i][0], vlo[i][1], vlo[i][2], vlo[i][3], vhi[i][0], vhi[i][1], vhi[i][2], vhi[i][3]}
#define PAF(k) __builtin_bit_cast(bf16x8, pw##k)
#define PV_MMA() do { \
        o[0] = __builtin_amdgcn_mfma_f32_32x32x16_bf16(PAF(0), VFR(0), o[0], 0, 0, 0); o[1] = __builtin_amdgcn_mfma_f32_32x32x16_bf16(PAF(0), VFR(4), o[1], 0, 0, 0); \
        o[0] = __builtin_amdgcn_mfma_f32_32x32x16_bf16(PAF(1), VFR(1), o[0], 0, 0, 0); o[1] = __builtin_amdgcn_mfma_f32_32x32x16_bf16(PAF(1), VFR(5), o[1], 0, 0, 0); \
        o[0] = __builtin_amdgcn_mfma_f32_32x32x16_bf16(PAF(2), VFR(2), o[0], 0, 0, 0); o[1] = __builtin_amdgcn_mfma_f32_32x32x16_bf16(PAF(2), VFR(6), o[1], 0, 0, 0); \
        o[0] = __builtin_amdgcn_mfma_f32_32x32x16_bf16(PAF(3), VFR(3), o[0], 0, 0, 0); o[1] = __builtin_amdgcn_mfma_f32_32x32x16_bf16(PAF(3), VFR(7), o[1], 0, 0, 0); \
        SBAR(); } while (0)
    int ks = 0, vs = 0;
    if (wid < 8) {
        for (int t = 0; t < NT; ++t) {
            if (t + 1 < NT) { WAIT_BAR(3); } else { WAIT_BAR(0); }
            K_LOAD(ks);
            if (t + 2 < NT) DMA_TILE(t + 2, (ks == 0) ? 2 : ks - 1, (vs + 2) & 3);
            SBAR();
            QK_MMA(t);
            V_LOAD(vs);
            SOFTMAX();
            PV_MMA();
            ks = (ks == 2) ? 0 : ks + 1; vs = (vs + 1) & 3;
        }
    } else {
        for (int t = 0; t < NT; ++t) {
            if (t + 1 < NT) { WAIT_BAR(3); } else { WAIT_BAR(0); }
            if (t > 0) V_LOAD((vs + 3) & 3);
            if (t + 2 < NT) DMA_TILE(t + 2, (ks == 0) ? 2 : ks - 1, (vs + 2) & 3);
            SBAR();
            if (t > 0) SOFTMAX();
            K_LOAD(ks);
            if (t > 0) PV_MMA();
            QK_MMA(t);
            ks = (ks == 2) ? 0 : ks + 1; vs = (vs + 1) & 3;
        }
        V_LOAD((vs + 3) & 3);
        SOFTMAX();
        PV_MMA();
    }
#undef K_LOAD
#undef V_LOAD
#undef QK_MMA
#undef SOFTMAX
#undef VFR
#undef PAF
#undef PV_MMA
    { auto rr = __builtin_amdgcn_permlane32_swap(__float_as_uint(l_run), __float_as_uint(l_run), false, false); l_run = __uint_as_float(rr[0]) + __uint_as_float(rr[1]); }
    if (hi == 0) wsf[32 + r32] = l_run; asm volatile("s_waitcnt lgkmcnt(0)" ::: "memory");
    float rli[16];
#pragma unroll
    for (int r = 0; r < 16; ++r) rli[r] = __builtin_amdgcn_rcpf(wsf[32 + crow(r, hi)]);
    bf16* Ow = O + (rowbase + q0 + wid * QBLK) * OP + h * 64;
    { LAS unsigned short* stg = (LAS unsigned short*)(shm + LDS_OST) + wid * 2048;
#pragma unroll
      for (int r = 0; r < 16; ++r) { const int orow = crow(r, hi);
#pragma unroll
          for (int d0 = 0; d0 < 2; ++d0) stg[orow * 64 + d0 * 32 + r32] = (unsigned short)(cvtpk_s(o[d0][r] * rli[r], 0.f) & 0xffffu); }
      asm volatile("s_waitcnt lgkmcnt(0)" ::: "memory");
#pragma unroll
      for (int i = 0; i < 4; ++i) { const int row = i * 8 + (lane >> 3), ch = lane & 7; const u32x4 v = *(const LAS u32x4*)(stg + row * 64 + ch * 8); *(u32x4*)(Ow + (long)row * OP + ch * 8) = v;
          float sq = 0.f;
#pragma unroll
          for (int k = 0; k < 4; ++k) { const float a = __uint_as_float(v[k] << 16), bq = __uint_as_float(v[k] & 0xffff0000u); sq += a * a + bq * bq; }
          sq += __shfl_xor(sq, 1); sq += __shfl_xor(sq, 2); sq += __shfl_xor(sq, 4);
          if (ch == 0) ASS[(rowbase + q0 + wid * QBLK + row) * 8 + h] = sq; } }
    asm volatile("s_waitcnt lgkmcnt(0)\n\ts_barrier" ::: "memory");
#undef DMA_TILE
}
#undef SBAR
#undef WAIT_BAR
}

#define XB_TMO      128
#define XB_XCNT(j)  (256  + 64 * (j))
#define XB_XSUB(j)  (1280 + 64 * (j))
#define XB_XGEN(j)  (2304 + 64 * (j))
#define XB_TOP      3328
#define XB_TOPGEN   3392
#define XCD_BAR_WORDS 3456
#define XB_LSUB(j)  (3456 + 64 * (j))
#define XB_LGEN(j)  (4480 + 64 * (j))
#define XB_SPIN_CAP (1u << 22)
__device__ __forceinline__ unsigned xb_ld(unsigned* p)              { return __hip_atomic_load(p, __ATOMIC_RELAXED, __HIP_MEMORY_SCOPE_AGENT); }
__device__ __forceinline__ unsigned xb_add(unsigned* p, unsigned v) { return __hip_atomic_fetch_add(p, v, __ATOMIC_RELAXED, __HIP_MEMORY_SCOPE_AGENT); }
__device__ __forceinline__ unsigned xb_xcc_id() { return (unsigned)__builtin_amdgcn_s_getreg((3 << 11) | 20) & 0xFu; }
#define XB_SPIN(cond, bar) do { unsigned _sp = 0; while (cond) { __builtin_amdgcn_s_sleep(1); \
    if ((++_sp & 255u) == 0u) { if (xb_ld(&(bar)[XB_TMO])) break; if (_sp > XB_SPIN_CAP) { atomicAdd(&(bar)[XB_TMO], 1u); break; } } } } while (0)
struct XcdBarrier { unsigned* bar; unsigned x; volatile LAS unsigned* st; };
__device__ __forceinline__ XcdBarrier xcd_barrier_post(unsigned* bar, volatile LAS unsigned* st) {
    XcdBarrier b; b.bar = bar; b.x = xb_xcc_id(); b.st = st;
    if (threadIdx.x == 0) st[10] = xb_add(&bar[XB_XCNT(b.x)], 1u);
    return b;
}
__device__ __forceinline__ void xcd_barrier_complete(unsigned* bar, unsigned x, unsigned& nloc, unsigned& nx) {
    const unsigned G = gridDim.x * gridDim.y * gridDim.z;
    unsigned sum, cnt, mine, sp = 0u;
    for (;;) {
        sum = 0u; cnt = 0u; mine = 0u;
#pragma unroll
        for (unsigned j = 0; j < 16; ++j) { const unsigned c = xb_ld(&bar[XB_XCNT(j)]); sum += c; cnt += (c > 0u) ? 1u : 0u; mine = (j == x) ? c : mine; }
        if (sum == G) break;
        __builtin_amdgcn_s_sleep(1);
        if ((++sp & 255u) == 0u) { if (xb_ld(&bar[XB_TMO])) break; if (sp > XB_SPIN_CAP) { atomicAdd(&bar[XB_TMO], 1u); break; } }
    }
    nloc = mine > 0u ? mine : 1u; nx = cnt > 0u ? cnt : 1u;
}
__device__ __forceinline__ void xcd_barrier(const XcdBarrier& b) {
    asm volatile("s_waitcnt vmcnt(0)" ::: "memory");
    __syncthreads();
    if (threadIdx.x == 0) {
        unsigned* bar = b.bar;
        __builtin_amdgcn_s_waitcnt(0);
        unsigned nloc = b.st[0], nx = b.st[1];
        if (nloc == 0u) { xcd_barrier_complete(bar, b.x, nloc, nx); b.st[0] = nloc; b.st[1] = nx; }
        const unsigned old = xb_add(&bar[XB_XSUB(b.x)], 1u);
        const unsigned gen = old / nloc;
        if (old + 1u == (gen + 1u) * nloc) {
            __builtin_amdgcn_fence(__ATOMIC_RELEASE, "agent");
            asm volatile("s_waitcnt vmcnt(0)" ::: "memory");
            const unsigned og = xb_add(&bar[XB_TOP], 1u);
            const unsigned tg = og / nx;
            if (og + 1u == (tg + 1u) * nx) xb_add(&bar[XB_TOPGEN], 1u);
            else XB_SPIN(xb_ld(&bar[XB_TOPGEN]) == tg, bar);
            __builtin_amdgcn_fence(__ATOMIC_ACQUIRE, "agent");
            xb_add(&bar[XB_XGEN(b.x)], 1u);
            asm volatile("s_waitcnt vmcnt(0)" ::: "memory");
        } else {
            XB_SPIN(xb_ld(&bar[XB_XGEN(b.x)]) == gen, bar);
            __builtin_amdgcn_fence(__ATOMIC_ACQUIRE, "agent");
            asm volatile("s_waitcnt vmcnt(0)" ::: "memory");
        }
    }
    __syncthreads();
}

__device__ __forceinline__ void xcd_local_barrier(const XcdBarrier& b, unsigned nloc) {
    asm volatile("s_waitcnt vmcnt(0)" ::: "memory");
    __syncthreads();
    if (threadIdx.x == 0) {
        unsigned* bar = b.bar;
        __builtin_amdgcn_s_waitcnt(0);
        const unsigned old = xb_add(&bar[XB_LSUB(b.x)], 1u);
        const unsigned gen = old / nloc;
        if (old + 1u == (gen + 1u) * nloc) xb_add(&bar[XB_LGEN(b.x)], 1u);
        else XB_SPIN(xb_ld(&bar[XB_LGEN(b.x)]) == gen, bar);
        __builtin_amdgcn_fence(__ATOMIC_ACQUIRE, "agent");
        asm volatile("s_waitcnt vmcnt(0)" ::: "memory");
    }
    __syncthreads();
}

struct Args { const void* in[23]; float* out; unsigned char* ws; };

__device__ __forceinline__ int ropeL(int p) { return ((p >> 2) & 1) * 16 + (p >> 3) * 4 + (p & 3); }
__device__ __forceinline__ int colmap(int id, int n) {
    if (id == 0) { if (n < 640) return n; if (n < 672) return 640 + ropeL(n - 640); if (n < 768) return -1; if (n < 1280) return n - 96;
                   const int q = n - 1280, T = q >> 8, bj = (q >> 7) & 1, j = q & 127; return (bj ? 1696 : 1184) + 128 * T + j; }
    if (id == 1) { const int pn = n >> 8, bj = (n >> 7) & 1, wc = (n >> 5) & 3, j = n & 31; if (pn < 2) return (4 * pn + wc) * 96 + 32 * bj + j; return (4 * bj + wc) * 96 + 64 + ropeL(j); }
    if (id == 2) { if (n < 512) { const int pn = n >> 8, bj = (n >> 7) & 1, wc = (n >> 5) & 3, j = n & 31; return (4 * pn + wc) * 128 + 32 * bj + j; } const int mm = n - 512; return (mm >> 6) * 128 + 64 + (mm & 63); }
    return n;
}
__device__ __forceinline__ void wconv_item(const float* W, int K, int Norig, int Nphys, bf16_t* WT, const float* gA, const float* gB, int split, int mapid, LAS float* scr, int item, int lane) {
    const int nblk = Nphys / 32, kb = item / nblk, nb = item % nblk, k0 = 64 * kb, n0 = 32 * nb;
    const int norig = colmap(mapid, n0 + (lane & 31));
    float wv[32];
#pragma unroll
    for (int i = 0; i < 32; ++i) { const int k = k0 + 2 * i + (lane >> 5); wv[i] = (norig >= 0) ? W[(size_t)k * Norig + norig] : 0.f; }
#pragma unroll
    for (int i = 0; i < 32; ++i) { const int kk = 2 * i + (lane >> 5), k = k0 + kk;
        float v = wv[i];
        if (gA) v *= (k < split ? gA[k] : gB[k - split]);
        scr[kk * 33 + (lane & 31)] = v; }
    asm volatile("s_waitcnt lgkmcnt(0)" ::: "memory");
    const int c = lane & 7;
#pragma unroll
    for (int j = 0; j < 4; ++j) { const int n = (lane >> 3) + 8 * j; const LAS float* s = scr + (8 * c) * 33 + n;
        u32x4 o; o.x = cvt_pk_bf16(s[0 * 33], s[1 * 33]); o.y = cvt_pk_bf16(s[2 * 33], s[3 * 33]); o.z = cvt_pk_bf16(s[4 * 33], s[5 * 33]); o.w = cvt_pk_bf16(s[6 * 33], s[7 * 33]);
        *(u32x4*)(WT + (size_t)(n0 + n) * K + k0 + 8 * c) = o; }
    asm volatile("s_waitcnt lgkmcnt(0)" ::: "memory");
}
template <class AP> __device__ __forceinline__ void convert_weights(AP a, int L, bf16_t* wb, LAS float* scr, int gw, int NGW, int lane) {
    constexpr int I0 = 16 * 72, I1 = 6 * 24, I2 = 4 * 32, I3 = 16 * 32, I4 = 16 * 128, I5 = 64 * 32, I6 = 16 * 32, I7 = 4 * 32;
    constexpr int NIT = I0 + I1 + I2 + I3 + I4 + I5 + I6 + I7;
    const float* g_mix = (const float*)a->in[3] + L * 1024; const float* w_in = (const float*)a->in[4] + (size_t)L * 1024 * INC;
    const float* g_ql = (const float*)a->in[5] + L * QL; const float* w_uq = (const float*)a->in[6] + (size_t)L * QL * 768;
    const float* g_kvl = (const float*)a->in[7] + L * KVL; const float* w_ukv = (const float*)a->in[8] + (size_t)L * KVL * 1024;
    const float* g_oa = (const float*)a->in[14] + L * 512; const float* g_oc = (const float*)a->in[15] + L * 512; const float* w_o = (const float*)a->in[16] + (size_t)L * 1024 * 1024;
    const float* g_mlp = (const float*)a->in[17] + L * 1024; const float* w_up = (const float*)a->in[18] + (size_t)L * 1024 * FF; const float* w_dn = (const float*)a->in[19] + (size_t)L * FF * 1024;
    const float* g_ple = (const float*)a->in[20] + L * 1024; const float* w_g = (const float*)a->in[21] + (size_t)L * 1024 * 1024; const float* w_ple = (const float*)a->in[22] + (size_t)L * PLE * 1024;
    for (int it = gw; it < NIT; it += NGW) {
        int r = it;
        if (r < I0) { wconv_item(w_in, 1024, INC, INP, wb + WO_IN, g_mix, g_mix, 1024, 0, scr, r, lane); continue; } r -= I0;
        if (r < I1) { wconv_item(w_uq, QL, 768, 768, wb + WO_UQ, g_ql, g_ql, QL, 1, scr, r, lane); continue; } r -= I1;
        if (r < I2) { wconv_item(w_ukv, KVL, 1024, 1024, wb + WO_UKV, g_kvl, g_kvl, KVL, 2, scr, r, lane); continue; } r -= I2;
        if (r < I3) { wconv_item(w_o, 1024, 1024, 1024, wb + WO_O, g_oa, g_oc, 512, 3, scr, r, lane); continue; } r -= I3;
        if (r < I4) { wconv_item(w_up, 1024, FF, FF, wb + WO_UP, g_mlp, g_mlp, 1024, 3, scr, r, lane); continue; } r -= I4;
        if (r < I5) { wconv_item(w_dn, FF, 1024, 1024, wb + WO_DN, nullptr, nullptr, 0, 3, scr, r, lane); continue; } r -= I5;
        if (r < I6) { wconv_item(w_g, 1024, 1024, 1024, wb + WO_G, g_ple, g_ple, 1024, 3, scr, r, lane); continue; } r -= I6;
        wconv_item(w_ple, PLE, 1024, 1024, wb + WO_PLE, nullptr, nullptr, 0, 3, scr, r, lane);
    }
}

#ifndef PH_MASK
#define PH_MASK 0xFFFF
#endif
#define PH(b) ((PH_MASK >> (b)) & 1)
__device__ __forceinline__ unsigned lds_word(unsigned byte_addr) { unsigned v; asm volatile("v_mov_b32 %0, %1\n\tds_read_b32 %0, %0\n\ts_waitcnt lgkmcnt(0)" : "=&v"(v) : "s"(byte_addr) : "memory"); return v; }
#define PHASE_ENV() \
    const __attribute__((address_space(4))) Args* ka_ = (const __attribute__((address_space(4))) Args*)__builtin_amdgcn_kernarg_segment_ptr(); asm volatile("" : "+s"(ka_)); \
    unsigned char* const ws = ka_->ws; float* const out = ka_->out; \
    int G = gridDim.x, bx = __builtin_amdgcn_readfirstlane((int)lds_word((unsigned)(__UINTPTR_TYPE__)lds + MISC_OFF + 64)); asm volatile("" : "+s"(G), "+s"(bx)); \
    const int vcu = (G % 8 == 0) ? (bx % 8) * (G / 8) + bx / 8 : bx; \
    int tidl_ = threadIdx.x; asm volatile("" : "+v"(tidl_)); const int tid = tidl_, lane = tid & 63, wave = __builtin_amdgcn_readfirstlane(tid >> 6); \
    const int gw = vcu * 8 + wave, NGW = G * 8; (void)gw; (void)NGW; (void)lane; (void)out; (void)tid; \
    bf16_t* const wb = (bf16_t*)(ws + WS_W0 + (size_t)(L % 3) * WS_WSTRIDE); (void)wb; \
    float* const XSA = (float*)(ws + (si ? WS_XS1 : WS_XS0)); float* const XSB = (float*)(ws + (si ? WS_XS0 : WS_XS1)); (void)XSA; (void)XSB;
#define KIN(i) ((const float*)ka_->in[i])

__global__ void __launch_bounds__(512, 2) trunk_fwd(Args args) {
    extern __shared__ __attribute__((aligned(16))) unsigned char lds_raw[];
    LAS unsigned char* lds = (LAS unsigned char*)lds_raw;
    volatile LAS unsigned* MISC = (volatile LAS unsigned*)(lds + MISC_OFF);
    for (int u = threadIdx.x; u < 32; u += 512) MISC[u] = (u == 16) ? blockIdx.x : 0u;
    __syncthreads();
    XcdBarrier bar = xcd_barrier_post((unsigned*)(args.ws + WS_CTL) + 1024, MISC + 8);
#define GRID_BAR() xcd_barrier(bar)

    {
        const int L = 0, si = 0;
        PHASE_ENV();
        if (PH(0)) { LAS float* scr = (LAS float*)(lds + wave * 16384); convert_weights(ka_, 0, (bf16_t*)(ws + WS_W0), scr, gw, NGW, lane); }
    }
    {
        const int L = 0, si = 0;
        PHASE_ENV();
        const float* x_in = KIN(0); bf16_t* XB = (bf16_t*)(ws + WS_XB);
        if (PH(1)) {
            f32x4 vn[4];
            if (gw < M) { const f32x4* xr = (const f32x4*)(x_in + (size_t)gw * 1024) + lane;
#pragma unroll
                for (int j = 0; j < 4; ++j) vn[j] = xr[64 * j]; }
            for (int m = gw; m < M; m += NGW) {
                f32x4 v[4]; float s = 0.f;
#pragma unroll
                for (int j = 0; j < 4; ++j) v[j] = vn[j];
                if (m + NGW < M) { const f32x4* xr = (const f32x4*)(x_in + (size_t)(m + NGW) * 1024) + lane;
#pragma unroll
                    for (int j = 0; j < 4; ++j) vn[j] = xr[64 * j]; }
#pragma unroll
                for (int j = 0; j < 4; ++j) s += dot4(v[j]);
                s = wave_sum(s);
                u32x2* o8 = (u32x2*)(XB + (size_t)m * 1024) + lane;
#pragma unroll
                for (int j = 0; j < 4; ++j) { u32x2 w; w.x = cvt_pk_bf16(v[j][0], v[j][1]); w.y = cvt_pk_bf16(v[j][2], v[j][3]); o8[64 * j] = w; }
                if (lane < 16) XSA[(size_t)m * 16 + lane] = (lane == 0) ? s : 0.f;
            }
        }
        const int* pos = (const int*)ka_->in[2]; float* COS = (float*)(ws + WS_COS); float* SIN = (float*)(ws + WS_SIN);
        if (PH(2)) for (int e = (bx * 512 + tid); e < M * 16; e += G * 512) {
            const int row = e >> 4, f = e & 15;
            const int fa = f & 3, fb = f >> 2;
            double inv = (fa == 0) ? 1.0 : (fa == 1) ? 0.5623413251903491 : (fa == 2) ? 0.31622776601683794 : 0.1778279410038923;
            inv *= (fb == 0) ? 1.0 : (fb == 1) ? 0.1 : (fb == 2) ? 0.01 : 0.001;
            const double ang = (double)pos[row] * inv;
            const double kk = __builtin_rint(ang * 0.15915494309189535);
            double r = __builtin_fma(-kk, 6.283185307179586, ang); r = __builtin_fma(-kk, 2.4492935982947064e-16, r);
            const double qd = __builtin_rint(r * 0.6366197723675814); const int qi = (int)qd;
            double y = __builtin_fma(-qd, 1.5707963267948966, r); y = __builtin_fma(-qd, 6.123233995736766e-17, y);
            const double y2 = y * y;
            double sp = -7.647163731819816e-13; sp = sp * y2 + 1.6059043836821613e-10; sp = sp * y2 - 2.505210838544172e-08; sp = sp * y2 + 2.7557319223985893e-06;
            sp = sp * y2 - 1.984126984126984e-04; sp = sp * y2 + 8.333333333333333e-03; sp = sp * y2 - 1.6666666666666666e-01; sp = y + y * y2 * sp;
            double cp = 4.779477332387385e-14; cp = cp * y2 - 1.1470745597729725e-11; cp = cp * y2 + 2.08767569878681e-09; cp = cp * y2 - 2.755731922398589e-07;
            cp = cp * y2 + 2.48015873015873e-05; cp = cp * y2 - 1.388888888888889e-03; cp = cp * y2 + 4.1666666666666664e-02; cp = cp * y2 - 0.5; cp = 1.0 + y2 * cp;
            const int qm = qi & 3;
            const double sv = (qm == 0) ? sp : (qm == 1) ? cp : (qm == 2) ? -sp : -cp;
            const double cv = (qm == 0) ? cp : (qm == 1) ? -sp : (qm == 2) ? -cp : sp;
            COS[e] = (float)cv; SIN[e] = (float)sv;
        }
    }
    if (args.ws == nullptr) cg::this_grid().sync();
    GRID_BAR();
    if (threadIdx.x == 0) {
        unsigned* bw = (unsigned*)(args.ws + WS_CTL) + 1024; const unsigned x = xb_xcc_id();
        unsigned pop = 0u, dense = 0u; bool ok = (gridDim.x == 256u);
#pragma unroll
        for (unsigned j = 0; j < 16; ++j) { const unsigned c = xb_ld(&bw[XB_XCNT(j)]); if (c) { ++pop; if (c != 32u) ok = false; if (j < x) ++dense; } }
        ok = ok && (pop == 8u);
        if (ok) { MISC[16] = MISC[18] * 8u + dense; MISC[17] = 1u; }
    }
    __syncthreads();
#define SEAM_LOCAL() do { if (__builtin_amdgcn_readfirstlane((int)lds_word((unsigned)(__UINTPTR_TYPE__)lds + MISC_OFF + 68))) xcd_local_barrier(bar, 32u); else xcd_barrier(bar); } while (0)

    int si = 0;
#pragma nounroll
    for (int L = 0; L < DEPTH; ++L) {
        if (PH(3)) {
            PHASE_ENV();
            pg8::Gemm g{(L == 0) ? (bf16_t*)(ws + WS_XB) : (bf16_t*)out, wb + WO_IN, M, INP, 1024, 1024}; pg8::StaticOrder S; S.init(M, INP, G, bx);
            pg8::EpiIn E{(bf16_t*)(ws + WS_Z), XSA, (float*)(ws + WS_ZS), (bf16_t*)(ws + WS_KPE), (const float*)(ws + WS_COS), (const float*)(ws + WS_SIN), KIN(12) + L * 32};
            pg8::gemm_phase(lds, g, S, E);
        }
        SEAM_LOCAL();
        if (PH(4)) {
            PHASE_ENV();
            pg8::Gemm g{(bf16_t*)(ws + WS_Z), wb + WO_UQ, M, 768, QL, INP}; pg8::StaticOrder S; S.init(M, 768, G, bx);
            pg8::EpiQ E{(bf16_t*)(ws + WS_Q), (const float*)(ws + WS_ZS), KIN(9) + L * 64, KIN(10) + L * 32, (const float*)(ws + WS_COS), (const float*)(ws + WS_SIN)};
            pg8::gemm_phase(lds, g, S, E);
        }
        if (PH(5)) {
            PHASE_ENV();
            pg8::Gemm g{(bf16_t*)(ws + WS_Z) + QL, wb + WO_UKV, M, 1024, KVL, INP}; pg8::StaticOrder S; S.init(M, 1024, G, bx);
            pg8::EpiKV E{(bf16_t*)(ws + WS_KN), (bf16_t*)(ws + WS_V), (const float*)(ws + WS_ZS), KIN(11) + L * 64};
            pg8::gemm_phase(lds, g, S, E);
        }
        SEAM_LOCAL();
        if (PH(6)) {
            PHASE_ENV();
            if (wave >= 4) __builtin_amdgcn_s_setprio(1);
            if (G == 256) {
                const int x = vcu >> 5, c = vcu & 31, i = c & 7;
                for (int r = 0; r < 2; ++r) {
                    const int bh = x * 8 + r * 4 + (c >> 3);
                    attn::attn_unit(bh >> 3, bh & 7, 15 - i, (const attn::bf16*)(ws + WS_Q), (const attn::bf16*)(ws + WS_KN), (const attn::bf16*)(ws + WS_KPE), (const attn::bf16*)(ws + WS_V), (attn::bf16*)(ws + WS_MIX), (float*)(ws + WS_ASS), (LAS char*)lds);
                    attn::attn_unit(bh >> 3, bh & 7, i, (const attn::bf16*)(ws + WS_Q), (const attn::bf16*)(ws + WS_KN), (const attn::bf16*)(ws + WS_KPE), (const attn::bf16*)(ws + WS_V), (attn::bf16*)(ws + WS_MIX), (float*)(ws + WS_ASS), (LAS char*)lds);
                }
            } else {
                for (int u = vcu; u < 64 * attn::NQB; u += G)
                    attn::attn_unit((u >> 4) >> 3, (u >> 4) & 7, u & 15, (const attn::bf16*)(ws + WS_Q), (const attn::bf16*)(ws + WS_KN), (const attn::bf16*)(ws + WS_KPE), (const attn::bf16*)(ws + WS_V), (attn::bf16*)(ws + WS_MIX), (float*)(ws + WS_ASS), (LAS char*)lds);
            }
            __builtin_amdgcn_s_setprio(0);
        }
        SEAM_LOCAL();
        if (PH(7)) {
            PHASE_ENV();
            const float* cw = KIN(13) + (size_t)L * 3 * 512;
            const float* pl = KIN(1) + (size_t)L * M * PLE;
            const bf16_t* Z = (const bf16_t*)(ws + WS_Z); bf16_t* MIX = (bf16_t*)(ws + WS_MIX); bf16_t* PB = (bf16_t*)(ws + WS_PB);
            for (int ch = gw; ch < M / 16; ch += NGW) {
                const int r0 = ch * 16, t0 = r0 & (SEQ - 1), c0 = lane * 8;
                float w0[8], w1[8], w2[8], u1[8], u2[8];
#pragma unroll
                for (int i = 0; i < 8; ++i) { w0[i] = cw[c0 + i]; w1[i] = cw[512 + c0 + i]; w2[i] = cw[1024 + c0 + i]; u1[i] = 0.f; u2[i] = 0.f; }
                if (t0 != 0) {
                    const u32x4 c1 = *(const u32x4*)(Z + (size_t)(r0 - 1) * INP + 1280 + c0), c2 = *(const u32x4*)(Z + (size_t)(r0 - 2) * INP + 1280 + c0);
#pragma unroll
                    for (int i = 0; i < 4; ++i) { u1[2 * i] = bf_lo(c1[i]); u1[2 * i + 1] = bf_hi(c1[i]); u2[2 * i] = bf_lo(c2[i]); u2[2 * i + 1] = bf_hi(c2[i]); }
                }
                u32x4 gb_n = *(const u32x4*)(Z + (size_t)r0 * INP + 768 + c0), gu_n = *(const u32x4*)(Z + (size_t)r0 * INP + 1280 + c0);
                f32x4 pv_n = *(const f32x4*)(pl + (size_t)r0 * PLE + lane * 4);
#pragma nounroll
                for (int rr = 0; rr < 16; ++rr) {
                    const int r = r0 + rr;
                    const u32x4 gb = gb_n, gu = gu_n; const f32x4 pv4 = pv_n;
                    if (rr < 15) { gb_n = *(const u32x4*)(Z + (size_t)(r + 1) * INP + 768 + c0); gu_n = *(const u32x4*)(Z + (size_t)(r + 1) * INP + 1280 + c0);
                                   pv_n = *(const f32x4*)(pl + (size_t)(r + 1) * PLE + lane * 4); }
                    float cv[8], uu[8]; float ss = 0.f;
#pragma unroll
                    for (int i = 0; i < 4; ++i) {
                        uu[2 * i] = bf_lo(gu[i]); uu[2 * i + 1] = bf_hi(gu[i]);
                        cv[2 * i] = bf_lo(gb[i]) * (w0[2 * i] * uu[2 * i] + w1[2 * i] * u1[2 * i] + w2[2 * i] * u2[2 * i]);
                        cv[2 * i + 1] = bf_hi(gb[i]) * (w0[2 * i + 1] * uu[2 * i + 1] + w1[2 * i + 1] * u1[2 * i + 1] + w2[2 * i + 1] * u2[2 * i + 1]);
                    }
#pragma unroll
                    for (int i = 0; i < 8; ++i) { ss += cv[i] * cv[i]; u2[i] = u1[i]; u1[i] = uu[i]; }
                    ss = wave_sum(ss);
                    const float rc = rsqrtf(ss * (1.0f / 512.0f) + EPS);
                    u32x4 oc;
#pragma unroll
                    for (int i = 0; i < 4; ++i) oc[i] = cvt_pk_bf16(cv[2 * i] * rc, cv[2 * i + 1] * rc);
                    *(u32x4*)(MIX + (size_t)r * 1024 + 512 + c0) = oc;
                    u32x2 pw; pw.x = cvt_pk_bf16(pv4[0], pv4[1]); pw.y = cvt_pk_bf16(pv4[2], pv4[3]);
                    *(u32x2*)(PB + (size_t)r * PLE + lane * 4) = pw;
                }
            }
            if (L + 1 < DEPTH) { LAS float* scr = (LAS float*)(lds + wave * 16384); convert_weights(ka_, L + 1, (bf16_t*)(ws + WS_W0 + (size_t)((L + 1) % 3) * WS_WSTRIDE), scr, gw, NGW, lane); }
        }
        GRID_BAR();
        if (PH(8)) {
            PHASE_ENV();
            pg8::Gemm g{(bf16_t*)(ws + WS_MIX), wb + WO_O, M, 1024, 1024, 1024}; pg8::StaticOrder S; S.init(M, 1024, G, bx);
            pg8::EpiRes<0, false> E{(L == 0) ? (const bf16_t*)(ws + WS_XB) : (const bf16_t*)out, (bf16_t*)(ws + WS_XB), nullptr, XSB, nullptr, nullptr, (const float*)(ws + WS_ASS)};
            pg8::gemm_phase<pg8::EpiRes<0, false>, true>(lds, g, S, E);
        }
        SEAM_LOCAL();
        if (PH(9)) {
            PHASE_ENV();
            pg8::Gemm g{(bf16_t*)(ws + WS_XB), wb + WO_UP, M, FF, 1024, 1024}; pg8::StaticOrder S; S.init(M, FF, G, bx);
            pg8::EpiUp E{(bf16_t*)(ws + WS_H)};
            pg8::gemm_phase(lds, g, S, E);
        }
        SEAM_LOCAL();
        if (PH(10)) {
            PHASE_ENV();
            pg8::Gemm g{(bf16_t*)(ws + WS_H), wb + WO_DN, M, 1024, FF, FF}; pg8::StaticOrder S; S.init(M, 1024, G, bx);
            pg8::EpiRes<2, false> E{(const bf16_t*)(ws + WS_XB), (bf16_t*)(ws + WS_XB), nullptr, XSA, XSB, nullptr};
            pg8::gemm_phase(lds, g, S, E);
        }
        if (L + 1 < DEPTH) SEAM_LOCAL(); else GRID_BAR();
        if (PH(11)) {
            { PHASE_ENV();
              pg8::Gemm g2{(bf16_t*)(ws + WS_PB), wb + WO_PLE, M, 1024, PLE, PLE}; pg8::StaticOrder S; S.init(M, 1024, G, bx);
              pg8::EpiPg E2{(bf16_t*)(ws + WS_MIX)};
              pg8::gemm_phase(lds, g2, S, E2); }
            { PHASE_ENV();
              pg8::Gemm g1{(bf16_t*)(ws + WS_XB), wb + WO_G, M, 1024, 1024, 1024}; pg8::StaticOrder S; S.init(M, 1024, G, bx);
              if (L + 1 < DEPTH) { pg8::EpiRes<1, false> E1{(const bf16_t*)(ws + WS_XB), (bf16_t*)out, nullptr, XSB, XSA, (const bf16_t*)(ws + WS_MIX)}; pg8::gemm_phase(lds, g1, S, E1); }
              else { pg8::EpiRes<1, true> E1{(const bf16_t*)(ws + WS_XB), nullptr, out, nullptr, XSA, (const bf16_t*)(ws + WS_MIX)}; pg8::gemm_phase(lds, g1, S, E1); } }
        }
        if (L + 1 < DEPTH) GRID_BAR();
        si ^= 1;
    }
}

extern "C" void kernel_launch(void* const* d_in, const int* in_sizes, int n_in, void* d_out, int out_size, void* d_ws, size_t ws_size, hipStream_t stream) {
    static int grid = 0;
    if (grid == 0) {
        if (n_in != 23 || in_sizes[0] != M * DMODEL || out_size != M * DMODEL || ws_size < WS_END) {
            fprintf(stderr, "kernel_launch: unexpected shapes (n_in %d, in0 %d, out %d, ws %zu); nothing launched\n", n_in, n_in > 0 ? in_sizes[0] : -1, out_size, ws_size); grid = -1; return; }
        int dev = 0, cus = 0, per_cu = 0;
        if (hipGetDevice(&dev) != hipSuccess || hipDeviceGetAttribute(&cus, hipDeviceAttributeMultiprocessorCount, dev) != hipSuccess) { grid = -1; return; }
        if (hipFuncSetAttribute((const void*)trunk_fwd, hipFuncAttributeMaxDynamicSharedMemorySize, LDS_BYTES) != hipSuccess) { fprintf(stderr, "kernel_launch: hipFuncSetAttribute failed\n"); grid = -1; return; }
        if (hipOccupancyMaxActiveBlocksPerMultiprocessor(&per_cu, (const void*)trunk_fwd, 512, LDS_BYTES) != hipSuccess || per_cu < 1) { fprintf(stderr, "kernel_launch: occupancy query says %d\n", per_cu); per_cu = 1; }
        (void)hipGetLastError();
        grid = cus * 1;
    }
    if (grid < 0) return;
    (void)hipMemsetAsync((char*)d_ws + WS_CTL, 0, CTL_ZERO_BYTES, stream);
    Args a{};
    for (int i = 0; i < 23; ++i) a.in[i] = d_in[i];
    a.out = (float*)d_out; a.ws = (unsigned char*)d_ws;
    void* kargs[] = {&a};
    hipError_t e = hipLaunchCooperativeKernel((const void*)trunk_fwd, dim3(grid), dim3(512), kargs, LDS_BYTES, stream);
    if (e != hipSuccess) fprintf(stderr, "kernel_launch: cooperative launch failed: %s (grid %d)\n", hipGetErrorString(e), grid);
}
```
